# Optimizing an MI355X kernel written in HIP

```python
import jax, jax.numpy as jnp
from jax import lax
import numpy as np

D_MODEL = 1024
BATCH = 8
SEQ = 2048
DEPTH = 4

N_MIXERS = 3
EPS = 1e-6
CHUNK = 128
E_A = 2 * D_MODEL
G_A = 8
E_B = 3 * D_MODEL // 2
H_B = 16
BD_B = E_B // H_B
CONV_W = 4
LRU_C = 8.0
H_C = 16
DH_C = D_MODEL // H_C
E_C = H_C * DH_C
Q_BLOCK = 128

kernel_name = "hybrid_gmlp_rglru_fox_trunk"


def rms_norm(x, g):
    xf = x.astype(jnp.float32)
    y = xf * lax.rsqrt(jnp.mean(xf * xf, axis=-1, keepdims=True) + EPS)
    return (y * g.astype(jnp.float32)).astype(x.dtype)


def gmlp_mixer(h, w_in, v_norm, w_s, b_s, w_out):
    B, S, _ = h.shape
    u, v, g = jnp.split(h @ w_in, 3, axis=-1)
    u = jax.nn.gelu(u)
    v = rms_norm(jax.nn.gelu(v), v_norm)
    vc = v.reshape(B, S // CHUNK, CHUNK, G_A, E_A // G_A)
    causal = jnp.tril(jnp.ones((CHUNK, CHUNK), dtype=bool))
    w = jnp.where(causal[None], w_s, 0.0).astype(v.dtype)
    mixed = jnp.einsum('gts,bcsgd->bctgd', w, vc) + b_s.T[None, None, :, :, None].astype(v.dtype)
    y = u * mixed.reshape(B, S, E_A) * jax.nn.silu(g)
    return y @ w_out


def _lru_combine(left, right):
    a_l, b_l = left
    a_r, b_r = right
    return a_l * a_r, a_r * b_l + b_r


def rglru_mixer(h, w_in, conv_w, conv_b, w_a, b_a, w_x, b_x, lam, w_out):
    B, S, _ = h.shape
    xb, g = jnp.split(h @ w_in, 2, axis=-1)
    xc = lax.conv_general_dilated(
        xb, conv_w[:, None, :].astype(xb.dtype), window_strides=(1,), padding=[(CONV_W - 1, 0)],
        dimension_numbers=('NWC', 'WIO', 'NWC'), feature_group_count=E_B) + conv_b.astype(xb.dtype)
    xh = xc.reshape(B, S, H_B, BD_B)
    r = jax.nn.sigmoid((jnp.einsum('bshi,hij->bshj', xh, w_a).reshape(B, S, E_B) + b_a).astype(jnp.float32))
    i = jax.nn.sigmoid((jnp.einsum('bshi,hij->bshj', xh, w_x).reshape(B, S, E_B) + b_x).astype(jnp.float32))
    log_a = -LRU_C * r * jax.nn.softplus(-lam.astype(jnp.float32))
    a = jnp.exp(log_a)
    inp = jnp.sqrt(-jnp.expm1(2.0 * log_a)) * (i * xc.astype(jnp.float32))
    _, hs = lax.associative_scan(_lru_combine, (a, inp), axis=1)
    y = hs.astype(h.dtype) * jax.nn.silu(g)
    return y @ w_out


def fox_mixer(h, w_in, b_f, q_norm, k_norm, w_out):
    B, S, _ = h.shape
    q, k, v, g, f_logit = jnp.split(h @ w_in, [E_C, 2 * E_C, 3 * E_C, 4 * E_C], axis=-1)
    q = rms_norm(q.reshape(B, S, H_C, DH_C), q_norm)
    k = rms_norm(k.reshape(B, S, H_C, DH_C), k_norm)
    v = v.reshape(B, S, H_C, DH_C)
    log_f = jax.nn.log_sigmoid(f_logit.astype(jnp.float32) + b_f.astype(jnp.float32))
    cum = jnp.cumsum(log_f, axis=1).transpose(0, 2, 1)
    scale = DH_C ** -0.5
    outs = []
    for q0 in range(0, S, Q_BLOCK):
        end = q0 + Q_BLOCK
        s = jnp.einsum('bqhd,bkhd->bhqk', q[:, q0:end], k[:, :end]).astype(jnp.float32) * scale
        s = s + cum[:, :, q0:end, None] - cum[:, :, None, :end]
        qi = jnp.arange(q0, end)[:, None]
        ki = jnp.arange(end)[None, :]
        s = jnp.where(ki <= qi, s, -jnp.inf)
        p = jax.nn.softmax(s, axis=-1).astype(v.dtype)
        outs.append(jnp.einsum('bhqk,bkhd->bqhd', p, v[:, :end]))
    o = jnp.concatenate(outs, axis=1).reshape(B, S, E_C)
    y = o * jax.nn.silu(g)
    return y @ w_out


def _nrm(k, shape, scale):
    return jax.random.normal(k, shape, jnp.float32) * scale


def _init_gmlp(key, p):
    k = jax.random.split(key, 6)
    return {
        p + 'norm': 1.0 + _nrm(k[0], (D_MODEL,), 0.02),
        p + 'w_in': _nrm(k[1], (D_MODEL, 3 * E_A), D_MODEL ** -0.5),
        p + 'v_norm': 1.0 + _nrm(k[2], (E_A,), 0.02),
        p + 'w_s': _nrm(k[3], (G_A, CHUNK, CHUNK), 0.5 * CHUNK ** -0.5),
        p + 'b_s': 1.0 + _nrm(k[4], (G_A, CHUNK), 0.02),
        p + 'w_out': _nrm(k[5], (E_A, D_MODEL), E_A ** -0.5),
    }


def _init_rglru(key, p):
    k = jax.random.split(key, 10)
    a0 = jax.random.uniform(k[8], (E_B,), jnp.float32, 0.9, 0.999)
    s0 = a0 ** (1.0 / LRU_C)
    return {
        p + 'norm': 1.0 + _nrm(k[0], (D_MODEL,), 0.02),
        p + 'w_in': _nrm(k[1], (D_MODEL, 2 * E_B), D_MODEL ** -0.5),
        p + 'conv_w': _nrm(k[2], (CONV_W, E_B), CONV_W ** -0.5),
        p + 'conv_b': _nrm(k[3], (E_B,), 0.02),
        p + 'w_a': _nrm(k[4], (H_B, BD_B, BD_B), BD_B ** -0.5),
        p + 'b_a': _nrm(k[5], (E_B,), 0.02),
        p + 'w_x': _nrm(k[6], (H_B, BD_B, BD_B), BD_B ** -0.5),
        p + 'b_x': _nrm(k[7], (E_B,), 0.02),
        p + 'lam': jnp.log(s0) - jnp.log1p(-s0),
        p + 'w_out': _nrm(k[9], (E_B, D_MODEL), E_B ** -0.5),
    }


def _init_fox(key, p):
    k = jax.random.split(key, 6)
    return {
        p + 'norm': 1.0 + _nrm(k[0], (D_MODEL,), 0.02),
        p + 'w_in': _nrm(k[1], (D_MODEL, 4 * E_C + H_C), D_MODEL ** -0.5),
        p + 'b_f': jax.random.uniform(k[2], (H_C,), jnp.float32, 1.0, 4.0),
        p + 'q_norm': 1.0 + _nrm(k[3], (DH_C,), 0.02),
        p + 'k_norm': 1.0 + _nrm(k[4], (DH_C,), 0.02),
        p + 'w_out': _nrm(k[5], (E_C, D_MODEL), E_C ** -0.5),
    }


def setup_inputs(seed: int = 0) -> dict:
    key = jax.random.key(seed)
    keys = jax.random.split(key, DEPTH + 1)
    inputs = {'x': jax.random.normal(keys[0], (BATCH, SEQ, D_MODEL), jnp.float32)}
    builders = (_init_gmlp, _init_rglru, _init_fox)
    for i in range(DEPTH):
        inputs.update(builders[i % N_MIXERS](keys[i + 1], 'l%d_' % i))
    return inputs


def reference(x,
              l0_norm, l0_w_in, l0_v_norm, l0_w_s, l0_b_s, l0_w_out,
              l1_norm, l1_w_in, l1_conv_w, l1_conv_b, l1_w_a, l1_b_a, l1_w_x, l1_b_x, l1_lam, l1_w_out,
              l2_norm, l2_w_in, l2_b_f, l2_q_norm, l2_k_norm, l2_w_out,
              l3_norm, l3_w_in, l3_v_norm, l3_w_s, l3_b_s, l3_w_out):
    layers = [
        (l0_norm, (l0_w_in, l0_v_norm, l0_w_s, l0_b_s, l0_w_out)),
        (l1_norm, (l1_w_in, l1_conv_w, l1_conv_b, l1_w_a, l1_b_a, l1_w_x, l1_b_x, l1_lam, l1_w_out)),
        (l2_norm, (l2_w_in, l2_b_f, l2_q_norm, l2_k_norm, l2_w_out)),
        (l3_norm, (l3_w_in, l3_v_norm, l3_w_s, l3_b_s, l3_w_out)),
    ]
    mixers = (gmlp_mixer, rglru_mixer, fox_mixer)
    for i in range(DEPTH):
        norm, params = layers[i]
        x = x + mixers[i % N_MIXERS](rms_norm(x, norm), *params).astype(x.dtype)
    return x
```

```cpp
#include <hip/hip_runtime.h>
#include <cstdio>
#include <cstdint>

namespace nv {
constexpr int D = 1024, NB = 8, S = 2048;
constexpr float EPS = 1e-6f;

__device__ __forceinline__ float gelu_tanh(float x) { return 0.5f * x * (1.0f + tanhf(0.7978845608028654f * (x + 0.044715f * x * x * x))); }
__device__ __forceinline__ float silu(float x) { return x / (1.0f + expf(-x)); }
__device__ __forceinline__ float sigmoidf_(float x) { return 1.0f / (1.0f + expf(-x)); }

__device__ __forceinline__ float block_sum256(float v, float* red) {
#pragma unroll
    for (int o = 32; o > 0; o >>= 1) v += __shfl_xor(v, o);
    __syncthreads();
    if ((threadIdx.x & 63) == 0) red[threadIdx.x >> 6] = v;
    __syncthreads();
    return red[0] + red[1] + red[2] + red[3];
}

__global__ __launch_bounds__(256) void rmsnorm_rows(const float* x, const float* g, float* h) {
    __shared__ float red[4];
    const size_t row = blockIdx.x; const float* xr = x + row * D; float v[4]; float ss = 0.f;
#pragma unroll
    for (int i = 0; i < 4; ++i) { v[i] = xr[threadIdx.x + 256 * i]; ss += v[i] * v[i]; }
    ss = block_sum256(ss, red);
    const float rstd = rsqrtf(ss * (1.0f / D) + EPS);
#pragma unroll
    for (int i = 0; i < 4; ++i) h[row * D + threadIdx.x + 256 * i] = v[i] * rstd * g[threadIdx.x + 256 * i];
}

__global__ __launch_bounds__(256) void gemm(const float* A, int lda, const float* W, int ldw, float* C, int ldc, const float* R, int ldr, int N, int K) {
    __shared__ float As[16][68];
    __shared__ float Ws[16][68];
    const int tid = threadIdx.x, tx = tid & 15, ty = tid >> 4;
    const int m0 = blockIdx.y * 64, n0 = blockIdx.x * 64;
    float acc[4][4];
#pragma unroll
    for (int i = 0; i < 4; ++i)
#pragma unroll
        for (int j = 0; j < 4; ++j) acc[i][j] = 0.f;
    const int ar = tid >> 2, ak = (tid & 3) * 4;
    const int wk = tid >> 4, wn = (tid & 15) * 4;
    for (int k0 = 0; k0 < K; k0 += 16) {
        const float4 av = *(const float4*)(A + (size_t)(m0 + ar) * lda + k0 + ak);
        float4 wv = make_float4(0.f, 0.f, 0.f, 0.f);
        if (n0 + wn < N) wv = *(const float4*)(W + (size_t)(k0 + wk) * ldw + n0 + wn);
        __syncthreads();
        As[ak + 0][ar] = av.x; As[ak + 1][ar] = av.y; As[ak + 2][ar] = av.z; As[ak + 3][ar] = av.w;
        *(float4*)&Ws[wk][wn] = wv;
        __syncthreads();
#pragma unroll
        for (int kk = 0; kk < 16; ++kk) {
            const float4 a = *(const float4*)&As[kk][ty * 4];
            const float4 w = *(const float4*)&Ws[kk][tx * 4];
            const float aa[4] = {a.x, a.y, a.z, a.w}, ww[4] = {w.x, w.y, w.z, w.w};
#pragma unroll
            for (int i = 0; i < 4; ++i)
#pragma unroll
                for (int j = 0; j < 4; ++j) acc[i][j] += aa[i] * ww[j];
        }
    }
    if (n0 + tx * 4 < N) {
#pragma unroll
        for (int i = 0; i < 4; ++i) {
            const size_t r = (size_t)(m0 + ty * 4 + i);
            float4 o = make_float4(acc[i][0], acc[i][1], acc[i][2], acc[i][3]);
            if (R) { const float4 rv = *(const float4*)(R + r * ldr + n0 + tx * 4); o.x += rv.x; o.y += rv.y; o.z += rv.z; o.w += rv.w; }
            *(float4*)(C + r * ldc + n0 + tx * 4) = o;
        }
    }
}

__global__ __launch_bounds__(256) void gmlp_vnorm(const float* uvg, const float* v_norm, float* vn) {
    __shared__ float red[4];
    const size_t t = blockIdx.x; const float* v = uvg + t * 6144 + 2048; float gv[8]; float ss = 0.f;
#pragma unroll
    for (int i = 0; i < 8; ++i) { gv[i] = gelu_tanh(v[threadIdx.x + 256 * i]); ss += gv[i] * gv[i]; }
    ss = block_sum256(ss, red);
    const float rstd = rsqrtf(ss * (1.0f / 2048.f) + EPS);
#pragma unroll
    for (int i = 0; i < 8; ++i) vn[t * 2048 + threadIdx.x + 256 * i] = gv[i] * rstd * v_norm[threadIdx.x + 256 * i];
}
__global__ __launch_bounds__(256) void gmlp_mix(const float* uvg, const float* vn, const float* w_s, const float* b_s, float* y) {
    const int c = blockIdx.x * 256 + threadIdx.x, t = blockIdx.y, g = c >> 8, tt = t & 127, c0 = t - tt;
    const float* wr = w_s + ((size_t)g * 128 + tt) * 128;
    float acc = 0.f;
    for (int s = 0; s <= tt; ++s) acc += wr[s] * vn[(size_t)(c0 + s) * 2048 + c];
    const float mixed = acc + b_s[g * 128 + tt];
    const float u = uvg[(size_t)t * 6144 + c], gate = uvg[(size_t)t * 6144 + 4096 + c];
    y[(size_t)t * 2048 + c] = gelu_tanh(u) * mixed * silu(gate);
}

__global__ __launch_bounds__(256) void lru_conv(const float* xg, const float* conv_w, const float* conv_b, float* xc) {
    const int c = blockIdx.x * 256 + threadIdx.x, t = blockIdx.y;
    float acc = conv_b[c];
#pragma unroll
    for (int w = 0; w < 4; ++w) { const int ts = t - 3 + w; if (ts >= 0) acc += conv_w[w * 1536 + c] * xg[(size_t)ts * 3072 + c]; }
    xc[(size_t)t * 1536 + c] = acc;
}
__global__ __launch_bounds__(256) void lru_gates(const float* xc, const float* w_a, const float* b_a, const float* w_x, const float* b_x, const float* lam, float* a_out, float* inp_out) {
    const int j = blockIdx.x * 256 + threadIdx.x, t = blockIdx.y, h = j / 96, jj = j - h * 96;
    const float* xr = xc + (size_t)t * 1536 + h * 96;
    const float* wa = w_a + (size_t)h * 96 * 96 + jj; const float* wx = w_x + (size_t)h * 96 * 96 + jj;
    float ga = b_a[j], gx = b_x[j];
    for (int i = 0; i < 96; ++i) { const float xv = xr[i]; ga += xv * wa[i * 96]; gx += xv * wx[i * 96]; }
    const float r = sigmoidf_(ga), ig = sigmoidf_(gx);
    const float sp = log1pf(expf(-lam[j]));
    const float log_a = -8.0f * r * sp;
    a_out[(size_t)t * 1536 + j] = expf(log_a);
    inp_out[(size_t)t * 1536 + j] = sqrtf(-expm1f(2.0f * log_a)) * (ig * xr[jj]);
}
__global__ __launch_bounds__(256) void lru_scan(const float* a, const float* inp, const float* xg, float* y) {
    const int j = blockIdx.x * 256 + threadIdx.x; float h = 0.f;
    for (int t = 0; t < S; ++t) { h = a[(size_t)t * 1536 + j] * h + inp[(size_t)t * 1536 + j]; y[(size_t)t * 1536 + j] = h * silu(xg[(size_t)t * 3072 + 1536 + j]); }
}

__global__ __launch_bounds__(64) void fox_prep(float* qkvgf, const float* q_norm, const float* k_norm, const float* b_f, float* logf) {
    const int t = blockIdx.x, lane = threadIdx.x;
    float* row = qkvgf + (size_t)t * 4112;
    for (int h = 0; h < 16; ++h) {
        float q = row[h * 64 + lane], k = row[1024 + h * 64 + lane];
        float sq = q * q, sk = k * k;
#pragma unroll
        for (int o = 32; o > 0; o >>= 1) { sq += __shfl_xor(sq, o); sk += __shfl_xor(sk, o); }
        row[h * 64 + lane] = q * rsqrtf(sq * (1.0f / 64.f) + EPS) * q_norm[lane];
        row[1024 + h * 64 + lane] = k * rsqrtf(sk * (1.0f / 64.f) + EPS) * k_norm[lane];
    }
    if (lane < 16) { const float xx = row[4096 + lane] + b_f[lane]; logf[t * 16 + lane] = fminf(xx, 0.f) - log1pf(expf(-fabsf(xx))); }
}
__global__ __launch_bounds__(64) void fox_cum(const float* logf, float* cum) {
    const int h = threadIdx.x; if (h >= 16) return; float c = 0.f;
    for (int t = 0; t < S; ++t) { c += logf[t * 16 + h]; cum[t * 16 + h] = c; }
}
__global__ __launch_bounds__(64) void fox_attn(const float* qkvgf, const float* cum, float* y) {
    const int h = blockIdx.y, q = blockIdx.x * 64 + threadIdx.x;
    const float* qr = qkvgf + (size_t)q * 4112 + h * 64;
    float qv[64], o[64];
#pragma unroll
    for (int d = 0; d < 64; ++d) { qv[d] = qr[d] * 0.125f; o[d] = 0.f; }
    const float cq = cum[q * 16 + h];
    float m = -INFINITY, l = 0.f;
    const int kend = blockIdx.x * 64 + 63;
    for (int k = 0; k <= kend; ++k) {
        const float* kr = qkvgf + (size_t)k * 4112 + 1024 + h * 64;
        const float* vr = qkvgf + (size_t)k * 4112 + 2048 + h * 64;
        float s = 0.f;
#pragma unroll
        for (int d = 0; d < 64; ++d) s += qv[d] * kr[d];
        s += cq - cum[k * 16 + h];
        if (k > q) s = -INFINITY;
        const float mn = fmaxf(m, s);
        const float alpha = (mn == -INFINITY) ? 1.f : expf(m - mn);
        const float p = (s == -INFINITY) ? 0.f : expf(s - mn);
        l = l * alpha + p;
#pragma unroll
        for (int d = 0; d < 64; ++d) o[d] = o[d] * alpha + p * vr[d];
        m = mn;
    }
    const float inv = 1.0f / l;
    const float* gr = qkvgf + (size_t)q * 4112 + 3072 + h * 64;
#pragma unroll
    for (int d = 0; d < 64; ++d) y[(size_t)q * 1024 + h * 64 + d] = o[d] * inv * silu(gr[d]);
}

struct LayerP { const float* p[10]; };

inline void layer_gmlp(const float* xin, float* xout, const float* const* P, float* scr, hipStream_t st) {
    const float *norm = P[0], *w_in = P[1], *v_norm = P[2], *w_s = P[3], *b_s = P[4], *w_out = P[5];
    float* H = scr; float* UVG = H + (size_t)S * D; float* VN = UVG + (size_t)S * 6144; float* Y = VN + (size_t)S * 2048;
    for (int b = 0; b < NB; ++b) {
        const float* xb = xin + (size_t)b * S * D; float* ob = xout + (size_t)b * S * D;
        rmsnorm_rows<<<S, 256, 0, st>>>(xb, norm, H);
        gemm<<<dim3(6144 / 64, S / 64), 256, 0, st>>>(H, D, w_in, 6144, UVG, 6144, nullptr, 0, 6144, D);
        gmlp_vnorm<<<S, 256, 0, st>>>(UVG, v_norm, VN);
        gmlp_mix<<<dim3(2048 / 256, S), 256, 0, st>>>(UVG, VN, w_s, b_s, Y);
        gemm<<<dim3(D / 64, S / 64), 256, 0, st>>>(Y, 2048, w_out, D, ob, D, xb, D, D, 2048);
    }
}
inline void layer_lru(const float* xin, float* xout, const float* const* P, float* scr, hipStream_t st) {
    const float *norm = P[0], *w_in = P[1], *conv_w = P[2], *conv_b = P[3], *w_a = P[4], *b_a = P[5], *w_x = P[6], *b_x = P[7], *lam = P[8], *w_out = P[9];
    float* H = scr; float* XG = H + (size_t)S * D; float* XC = XG + (size_t)S * 3072; float* A_ = XC + (size_t)S * 1536; float* INP = A_ + (size_t)S * 1536; float* Y = INP + (size_t)S * 1536;
    for (int b = 0; b < NB; ++b) {
        const float* xb = xin + (size_t)b * S * D; float* ob = xout + (size_t)b * S * D;
        rmsnorm_rows<<<S, 256, 0, st>>>(xb, norm, H);
        gemm<<<dim3(3072 / 64, S / 64), 256, 0, st>>>(H, D, w_in, 3072, XG, 3072, nullptr, 0, 3072, D);
        lru_conv<<<dim3(1536 / 256, S), 256, 0, st>>>(XG, conv_w, conv_b, XC);
        lru_gates<<<dim3(1536 / 256, S), 256, 0, st>>>(XC, w_a, b_a, w_x, b_x, lam, A_, INP);
        lru_scan<<<1536 / 256, 256, 0, st>>>(A_, INP, XG, Y);
        gemm<<<dim3(D / 64, S / 64), 256, 0, st>>>(Y, 1536, w_out, D, ob, D, xb, D, D, 1536);
    }
}
inline void layer_fox(const float* xin, float* xout, const float* const* P, float* scr, hipStream_t st) {
    const float *norm = P[0], *w_in = P[1], *b_f = P[2], *q_norm = P[3], *k_norm = P[4], *w_out = P[5];
    float* H = scr; float* QK = H + (size_t)S * D; float* LOGF = QK + (size_t)S * 4112; float* CUM = LOGF + (size_t)S * 16; float* Y = CUM + (size_t)S * 16;
    for (int b = 0; b < NB; ++b) {
        const float* xb = xin + (size_t)b * S * D; float* ob = xout + (size_t)b * S * D;
        rmsnorm_rows<<<S, 256, 0, st>>>(xb, norm, H);
        gemm<<<dim3((4112 + 63) / 64, S / 64), 256, 0, st>>>(H, D, w_in, 4112, QK, 4112, nullptr, 0, 4112, D);
        fox_prep<<<S, 64, 0, st>>>(QK, q_norm, k_norm, b_f, LOGF);
        fox_cum<<<1, 64, 0, st>>>(LOGF, CUM);
        fox_attn<<<dim3(S / 64, 16), 64, 0, st>>>(QK, CUM, Y);
        gemm<<<dim3(D / 64, S / 64), 256, 0, st>>>(Y, 1024, w_out, D, ob, D, xb, D, D, 1024);
    }
}
}

extern "C" void kernel_launch(void* const* d_in, const int* in_sizes, int n_in, void* d_out, int out_size, void* d_ws, size_t ws_size, hipStream_t stream) {
    const float* in[29];
    for (int i = 0; i < 29; ++i) in[i] = (const float*)d_in[i];
    float* out = (float*)d_out;
    float* scr = (float*)((char*)d_ws + (64u << 20));
    nv::layer_gmlp(in[0], out, in + 1, scr, stream);
    nv::layer_lru(out, out, in + 7, scr, stream);
    nv::layer_fox(out, out, in + 17, scr, stream);
    nv::layer_gmlp(out, out, in + 23, scr, stream);
}
```

```cpp
#include <hip/hip_runtime.h>
#include <cstdio>
#include <cstdint>
#ifndef PG8_WGM
#define PG8_WGM 8
#endif
namespace pg8 {
#define PG8_LAS __attribute__((address_space(3)))
typedef unsigned short bf16_t;
typedef short bf16x8 __attribute__((ext_vector_type(8)));
typedef float f32x4 __attribute__((ext_vector_type(4)));
typedef unsigned u32x4 __attribute__((ext_vector_type(4)));
constexpr int BM = 256, BK = 64, HALF = 128, HTB = HALF * BK * 2  , STAGE_BYTES = 8 * HTB, NXCD = 8, WGM = PG8_WGM;

__host__ __device__ __forceinline__ int lds_byte(int r, int c) { const int st = (r >> 4) * 2 + (c >> 5), rr = r & 15, cc = c & 31, ob = rr * 64 + cc * 2; return st * 1024 + (ob ^ (((ob >> 9) & 1) << 5)); }
__host__ __device__ __forceinline__ void stage_rc(int b, int& R, int& C) { const int st = b / 1024, sb = b % 1024, swz = sb ^ (((sb >> 9) & 1) << 5); R = (st >> 1) * 16 + swz / 64; C = (st & 1) * 32 + (swz % 64) / 2; }
__host__ __device__ __forceinline__ int perm32(int rho) { const int n = rho >> 4, i = rho & 15; return 8 * (i >> 2) + 4 * n + (i & 3); }

struct Unit { int pm, pn; };
struct Gemm { const bf16_t* A; const bf16_t* Bt; int M, N, K; };

struct StaticOrder {
    int nM, nN, nwg, G, c;
    __host__ __device__ void init(int M, int N, int G_, int c_) { nM = M / BM; nN = N / BM; nwg = nM * nN; G = G_; c = c_; }
    __host__ __device__ bool next(int i, Unit& u) const {
        const long L = (long)i * G + c; if (L >= nwg) return false;
        int wgid = (int)L; { const int q = nwg / NXCD, r = nwg % NXCD, xcd = wgid % NXCD, off = wgid / NXCD; wgid = (xcd < r ? xcd * (q + 1) : r * (q + 1) + (xcd - r) * q) + off; }
        const int nig = WGM * nN, gid = wgid / nig, fm = gid * WGM, gsz = (nM - fm) < WGM ? (nM - fm) : WGM;
        u.pm = fm + ((wgid % nig) % gsz); u.pn = (wgid % nig) / gsz; return true;
    }
    __device__ __forceinline__ void a_ready(const Unit&) const {}
    __device__ __forceinline__ void done(const Unit&) const {}
};

__device__ __forceinline__ unsigned cvt_pk_bf16(float lo, float hi) { unsigned r; asm volatile("v_cvt_pk_bf16_f32 %0, %1, %2" : "=v"(r) : "v"(lo), "v"(hi)); return r; }
typedef float f32x2 __attribute__((ext_vector_type(2)));
__device__ __forceinline__ float gelu_t(float x) { const float u = x * (1.0f + 0.044715f * x * x); return x * __builtin_amdgcn_rcpf(1.0f + __builtin_amdgcn_exp2f(-2.3022082f * u)); }
__device__ __forceinline__ float silu_f(float x) { return x * __builtin_amdgcn_rcpf(1.0f + __builtin_amdgcn_exp2f(-1.4426950409f * x)); }
__device__ __forceinline__ float row_rstd(const float* ssq, int row) { const f32x4 s = *(const f32x4*)(ssq + (size_t)row * 4); return rsqrtf(((s[0] + s[1]) + (s[2] + s[3])) * (1.0f / 1024.0f) + 1e-6f); }
typedef float f32x2v_ __attribute__((ext_vector_type(2))); typedef __bf16 bf16x2v_ __attribute__((ext_vector_type(2)));
__device__ __forceinline__ unsigned cvt2(float lo, float hi) { f32x2v_ v = {lo, hi}; return __builtin_bit_cast(unsigned, __builtin_convertvector(v, bf16x2v_)); }
__device__ __forceinline__ u32x4 pack8_old(const f32x4 a, const f32x4 b) { u32x4 w; w.x = cvt_pk_bf16(a[0], a[1]); w.y = cvt_pk_bf16(a[2], a[3]); w.z = cvt_pk_bf16(b[0], b[1]); w.w = cvt_pk_bf16(b[2], b[3]); return w; }

__device__ __forceinline__ void load_rstd8(const PG8_LAS float* tab, int ord, int wr, int fr, float (&rs)[2][4]) {
#pragma unroll
    for (int ai = 0; ai < 2; ++ai)
#pragma unroll
        for (int m = 0; m < 4; ++m) rs[ai][m] = tab[ord * 256 + wr * 64 + fr + ai * HALF + m * 16];
}
__device__ __forceinline__ u32x4 pack8(const f32x4 a, const f32x4 b) { u32x4 w; w.x = cvt2(a[0], a[1]); w.y = cvt2(a[2], a[3]); w.z = cvt2(b[0], b[1]); w.w = cvt2(b[2], b[3]); return w; }
__device__ __forceinline__ float gelu_silu(float u, float g) { const float t = u * u; const float e1 = __builtin_amdgcn_exp2f(fminf(u * fmaf(t, -0.10294324f, -2.3022082f), 60.0f)); const float e2 = __builtin_amdgcn_exp2f(fminf(-1.4426950409f * g, 60.0f));
    const float a1 = 1.0f + e1; return (u * g) * __builtin_amdgcn_rcpf(fmaf(a1, e2, a1)); }
__device__ __forceinline__ float gelu_t2(float x) { const float t = x * x; return x * __builtin_amdgcn_rcpf(1.0f + __builtin_amdgcn_exp2f(x * fmaf(t, -0.10294324f, -2.3022082f))); }

__device__ __forceinline__ f32x2 pk_fma2(f32x2 a, f32x2 b, f32x2 c) { return __builtin_elementwise_fma(a, b, c); }
__device__ __forceinline__ f32x2 lo2(const f32x4 v) { return (f32x2){v[0], v[1]}; }
__device__ __forceinline__ f32x2 hi2(const f32x4 v) { return (f32x2){v[2], v[3]}; }
__device__ __forceinline__ f32x2 gelu_p(f32x2 x) { const f32x2 t = x * x; const f32x2 a = x * pk_fma2(t, (f32x2){-0.10294324f, -0.10294324f}, (f32x2){-2.3022082f, -2.3022082f});
    const f32x2 d = (f32x2){__builtin_amdgcn_exp2f(a[0]), __builtin_amdgcn_exp2f(a[1])} + (f32x2){1.0f, 1.0f}; return x * (f32x2){__builtin_amdgcn_rcpf(d[0]), __builtin_amdgcn_rcpf(d[1])}; }
__device__ __forceinline__ f32x2 silu_p(f32x2 x) { const f32x2 a = x * (f32x2){-1.4426950409f, -1.4426950409f};
    const f32x2 d = (f32x2){__builtin_amdgcn_exp2f(a[0]), __builtin_amdgcn_exp2f(a[1])} + (f32x2){1.0f, 1.0f}; return x * (f32x2){__builtin_amdgcn_rcpf(d[0]), __builtin_amdgcn_rcpf(d[1])}; }
__device__ __forceinline__ f32x2 gelu_silu_p(f32x2 u, f32x2 g) { const f32x2 t = u * u; const f32x2 a = u * pk_fma2(t, (f32x2){-0.10294324f, -0.10294324f}, (f32x2){-2.3022082f, -2.3022082f}); const f32x2 b = g * (f32x2){-1.4426950409f, -1.4426950409f};
    const f32x2 a1 = (f32x2){__builtin_amdgcn_exp2f(fminf(a[0], 60.0f)), __builtin_amdgcn_exp2f(fminf(a[1], 60.0f))} + (f32x2){1.0f, 1.0f}; const f32x2 e2 = (f32x2){__builtin_amdgcn_exp2f(b[0]), __builtin_amdgcn_exp2f(b[1])};
    const f32x2 d = pk_fma2(a1, e2, a1); return (u * g) * (f32x2){__builtin_amdgcn_rcpf(d[0]), __builtin_amdgcn_rcpf(d[1])}; }
__device__ __forceinline__ u32x4 pack8p(const f32x2 a, const f32x2 b, const f32x2 c, const f32x2 d) { u32x4 w; w.x = cvt2(a[0], a[1]); w.y = cvt2(b[0], b[1]); w.z = cvt2(c[0], c[1]); w.w = cvt2(d[0], d[1]); return w; }

struct EpiGmlp1 {
    static constexpr bool PERM = true, AFTER_DRAIN = false;
    const PG8_LAS float* rtab; bf16_t* UG; bf16_t* GV; float* vssq; mutable int ord;
    __device__ __forceinline__ void operator()(const f32x4 (&acc)[2][2][4][2], const Unit& u, int wr, int wc, int fr, int fq) const {
        const int row0 = u.pm * BM + wr * 64 + fr; float rs8[2][4]; load_rstd8(rtab, ord++, wr, fr, rs8);
        if (u.pn < 16) {
            const int col = u.pn * 128 + wc * 32 + 8 * fq;
#pragma unroll
            for (int ai = 0; ai < 2; ++ai)
#pragma unroll
                for (int m = 0; m < 4; ++m) { const int r = row0 + ai * HALF + m * 16; const float rs = rs8[ai][m];
                    const f32x2 rs2 = {rs, rs};
                    const f32x2 o0 = gelu_silu_p(lo2(acc[ai][0][m][0]) * rs2, lo2(acc[ai][1][m][0]) * rs2), o1 = gelu_silu_p(hi2(acc[ai][0][m][0]) * rs2, hi2(acc[ai][1][m][0]) * rs2);
                    const f32x2 o2 = gelu_silu_p(lo2(acc[ai][0][m][1]) * rs2, lo2(acc[ai][1][m][1]) * rs2), o3 = gelu_silu_p(hi2(acc[ai][0][m][1]) * rs2, hi2(acc[ai][1][m][1]) * rs2);
                    *(u32x4*)(UG + (size_t)r * 2048 + col) = pack8p(o0, o1, o2, o3); asm volatile("" ::: "memory"); }
        } else {
            const int pv = u.pn - 16, col = pv * 256 + wc * 32 + 8 * fq;
#pragma unroll
            for (int ai = 0; ai < 2; ++ai)
#pragma unroll
                for (int m = 0; m < 4; ++m) { const int r = row0 + ai * HALF + m * 16; const float rs = rs8[ai][m]; const f32x2 rs2 = {rs, rs}; f32x2 ss2 = {0.f, 0.f};
#pragma unroll
                    for (int bj = 0; bj < 2; ++bj) {
                        const f32x2 o0 = gelu_p(lo2(acc[ai][bj][m][0]) * rs2), o1 = gelu_p(hi2(acc[ai][bj][m][0]) * rs2), o2 = gelu_p(lo2(acc[ai][bj][m][1]) * rs2), o3 = gelu_p(hi2(acc[ai][bj][m][1]) * rs2);
                        ss2 = pk_fma2(o0, o0, ss2); ss2 = pk_fma2(o1, o1, ss2); ss2 = pk_fma2(o2, o2, ss2); ss2 = pk_fma2(o3, o3, ss2);
                        *(u32x4*)(GV + (size_t)r * 2048 + col + bj * HALF) = pack8p(o0, o1, o2, o3); }
                    float ss = ss2[0] + ss2[1];
                    ss += __shfl_xor(ss, 16); ss += __shfl_xor(ss, 32);
                    if (fq == 0) vssq[(size_t)r * 32 + pv * 4 + wc] = ss; asm volatile("" ::: "memory"); }
        }
    }
};
struct EpiLru1 {
    static constexpr bool PERM = true, AFTER_DRAIN = false;
    const PG8_LAS float* rtab; bf16_t* XBR; bf16_t* SG; mutable int ord;
    __device__ __forceinline__ void operator()(const f32x4 (&acc)[2][2][4][2], const Unit& u, int wr, int wc, int fr, int fq) const {
        const int row0 = u.pm * BM + wr * 64 + fr; const bool gate = u.pn >= 6; float rs8[2][4]; load_rstd8(rtab, ord++, wr, fr, rs8);
        bf16_t* base = gate ? SG : XBR; const int col = (gate ? u.pn - 6 : u.pn) * 256 + wc * 32 + 8 * fq;
#pragma unroll
        for (int ai = 0; ai < 2; ++ai)
#pragma unroll
            for (int m = 0; m < 4; ++m) { const int r = row0 + ai * HALF + m * 16; const float rs = rs8[ai][m];
#pragma unroll
                for (int bj = 0; bj < 2; ++bj) { const f32x2 rs2 = {rs, rs}; f32x2 o0 = lo2(acc[ai][bj][m][0]) * rs2, o1 = hi2(acc[ai][bj][m][0]) * rs2, o2 = lo2(acc[ai][bj][m][1]) * rs2, o3 = hi2(acc[ai][bj][m][1]) * rs2;
                    if (gate) { o0 = silu_p(o0); o1 = silu_p(o1); o2 = silu_p(o2); o3 = silu_p(o3); }
                    *(u32x4*)(base + (size_t)r * 1536 + col + bj * HALF) = pack8p(o0, o1, o2, o3); } asm volatile("" ::: "memory"); }
    }
};
struct EpiFox1 {
    static constexpr bool PERM = true, AFTER_DRAIN = false;
    const PG8_LAS float* rtab; bf16_t* Q; bf16_t* Kt; bf16_t* V; bf16_t* SG; const PG8_LAS float* gtab; mutable int ord;
    __device__ __forceinline__ void operator()(const f32x4 (&acc)[2][2][4][2], const Unit& u, int wr, int wc, int fr, int fq) const {
        const int row0 = u.pm * BM + wr * 64 + fr; float rs8[2][4]; load_rstd8(rtab, ord++, wr, fr, rs8);
        if (u.pn < 8) {
            const bool isq = u.pn < 4; const PG8_LAS float* gn = gtab + (isq ? 0 : 64); bf16_t* base = isq ? Q : Kt;
            const int head = 4 * (u.pn & 3) + wc;
            f32x4 g[2][2];
#pragma unroll
            for (int bj = 0; bj < 2; ++bj)
#pragma unroll
                for (int n = 0; n < 2; ++n) g[bj][n] = *(const PG8_LAS f32x4*)(gn + 32 * bj + 8 * fq + 4 * n);
#pragma unroll
            for (int ai = 0; ai < 2; ++ai)
#pragma unroll
                for (int m = 0; m < 4; ++m) { const int r = row0 + ai * HALF + m * 16; const float rs = rs8[ai][m]; float ss = 0.f; f32x4 t[2][2];
#pragma unroll
                    for (int bj = 0; bj < 2; ++bj)
#pragma unroll
                        for (int n = 0; n < 2; ++n) { t[bj][n] = acc[ai][bj][m][n] * rs; ss += (t[bj][n][0] * t[bj][n][0] + t[bj][n][1] * t[bj][n][1]) + (t[bj][n][2] * t[bj][n][2] + t[bj][n][3] * t[bj][n][3]); }
                    ss += __shfl_xor(ss, 16); ss += __shfl_xor(ss, 32);
                    const float rh = rsqrtf(ss * (1.0f / 64.0f) + 1e-6f);
#pragma unroll
                    for (int bj = 0; bj < 2; ++bj) *(u32x4*)(base + (size_t)r * 1024 + 64 * head + 32 * bj + 8 * fq) = pack8(t[bj][0] * rh * g[bj][0], t[bj][1] * rh * g[bj][1]); asm volatile("" ::: "memory"); }
        } else {
            const bool gate = u.pn >= 12; bf16_t* base = gate ? SG : V; const int col = ((u.pn - 8) & 3) * 256 + wc * 32 + 8 * fq;
#pragma unroll
            for (int ai = 0; ai < 2; ++ai)
#pragma unroll
                for (int m = 0; m < 4; ++m) { const int r = row0 + ai * HALF + m * 16; const float rs = rs8[ai][m];
#pragma unroll
                    for (int bj = 0; bj < 2; ++bj) { const f32x2 rs2 = {rs, rs}; f32x2 o0 = lo2(acc[ai][bj][m][0]) * rs2, o1 = hi2(acc[ai][bj][m][0]) * rs2, o2 = lo2(acc[ai][bj][m][1]) * rs2, o3 = hi2(acc[ai][bj][m][1]) * rs2;
                        if (gate) { o0 = silu_p(o0); o1 = silu_p(o1); o2 = silu_p(o2); o3 = silu_p(o3); }
                        *(u32x4*)(base + (size_t)r * 1024 + col + bj * HALF) = pack8p(o0, o1, o2, o3); } asm volatile("" ::: "memory"); }
        }
    }
};
struct EpiRes {
    static constexpr bool PERM = true, AFTER_DRAIN = true;
    const float* xin; float* xout; bf16_t* XB; float* ssq; int mode;
    __device__ __forceinline__ void fused(f32x4 (&acc)[2][2][4][2], const Unit& u, int wr, int wc, int fr, int fq, PG8_LAS unsigned char* lds, int wid, int lane) const {
        const int row0 = u.pm * BM + wr * 64 + fr, col0 = u.pn * BM + wc * 32 + 8 * fq;
        PG8_LAS float* P = (PG8_LAS float*)lds;
        const bool wxb = mode != 2;
        u32x4 cur[2], nx1[2];
#define EPIRES_ROW(it_) (row0 + ((it_) >> 2) * HALF + ((it_) & 3) * 16)
#define EPIRES_LOAD(dst, it_) do { _Pragma("unroll") for (int bj = 0; bj < 2; ++bj) dst[bj] = *(const u32x4*)(XB + (size_t)EPIRES_ROW(it_) * 1024 + col0 + bj * HALF); } while (0)
        EPIRES_LOAD(cur, 0);
#pragma unroll
        for (int it = 0; it < 8; ++it) { const int ai = it >> 2, m = it & 3; const int r = EPIRES_ROW(it); float ss = 0.f;
            if (it < 7) EPIRES_LOAD(nx1, it + 1);
            asm volatile("" ::: "memory");
#pragma unroll
            for (int bj = 0; bj < 2; ++bj) { const size_t off = (size_t)r * 1024 + col0 + bj * HALF; const u32x4 w_ = cur[bj];
                const f32x4 c0 = (f32x4){__uint_as_float(w_.x << 16), __uint_as_float(w_.x & 0xffff0000u), __uint_as_float(w_.y << 16), __uint_as_float(w_.y & 0xffff0000u)};
                const f32x4 c1 = (f32x4){__uint_as_float(w_.z << 16), __uint_as_float(w_.z & 0xffff0000u), __uint_as_float(w_.w << 16), __uint_as_float(w_.w & 0xffff0000u)};
                const f32x4 o0 = c0 + acc[ai][bj][m][0], o1 = c1 + acc[ai][bj][m][1];
                if (!wxb) { __builtin_nontemporal_store(o0, (f32x4*)(xout + off)); __builtin_nontemporal_store(o1, (f32x4*)(xout + off + 4)); }
                else { *(u32x4*)(XB + off) = pack8(o0, o1);
                    ss += ((o0[0] * o0[0] + o0[1] * o0[1]) + (o0[2] * o0[2] + o0[3] * o0[3])) + ((o1[0] * o1[0] + o1[1] * o1[1]) + (o1[2] * o1[2] + o1[3] * o1[3])); } }
            if (wxb) { ss += __shfl_xor(ss, 16); ss += __shfl_xor(ss, 32); if (fq == 0) P[(ai * HALF + wr * 64 + m * 16 + fr) * 4 + wc] = ss; }
            asm volatile("" ::: "memory");
#pragma unroll
            for (int bj = 0; bj < 2; ++bj) cur[bj] = nx1[bj]; }
#undef EPIRES_LOAD
#undef EPIRES_ROW
        if (wxb) {
            asm volatile("s_waitcnt lgkmcnt(0)" ::: "memory"); __builtin_amdgcn_s_barrier(); asm volatile("" ::: "memory");
            const int t = wid * 64 + lane;
            if (t < 256) { const f32x4 p = *(const PG8_LAS f32x4*)(P + t * 4); ssq[(size_t)(u.pm * BM + t) * 4 + u.pn] = (p[0] + p[1]) + (p[2] + p[3]); }
        }
    }
};
template <class Epi, class Sched, bool ALIGN_EPI = false, bool SP2 = false>
__device__ __forceinline__ void gemm_phase(PG8_LAS unsigned char* lds, const Gemm g, const Sched& S, const Epi& E) {
    int tid_ = threadIdx.x; asm volatile("" : "+v"(tid_));
    const int tid = tid_, wid = __builtin_amdgcn_readfirstlane(tid >> 6), lane = tid & 63, wr = wid >> 2, wc = wid & 3, fr = lane & 15, fq = lane >> 4;
    const int K = g.K, nt = K / BK;
    unsigned voffA[2], voffB[2];
#pragma unroll
    for (int i = 0; i < 2; ++i) { int R, C; stage_rc(tid * 16 + i * 8192, R, C); const int Rb = Epi::PERM ? ((R & ~31) + perm32(R & 31)) : R;
        voffA[i] = (unsigned)(R * K + C) * 2u; voffB[i] = (unsigned)(Rb * K + C) * 2u; }
    const size_t kstep = (size_t)(BK * 2);
    const size_t hstep = (size_t)HALF * K * 2;
    const size_t tstep = 2 * hstep;
    const unsigned ldsw = (unsigned)wid * 1024u;
    const int aoff = lds_byte(wr * 64 + fr, fq * 8), boff = lds_byte(wc * 32 + fr, fq * 8);
#define PG8_SA(b, h) (((b) * 2 + (h)) * HTB)
#define PG8_SB(b, h) ((4 + (b) * 2 + (h)) * HTB)
#define PG8_STAGE(bufoff, gbase, voff) do { _Pragma("unroll") for (int _i = 0; _i < 2; ++_i) \
        __builtin_amdgcn_global_load_lds((const unsigned*)((const char*)(gbase) + (voff)[_i]), (PG8_LAS unsigned*)(lds + (bufoff) + ldsw + _i * 8192), 16, 0, 0); } while (0)
#define PG8_LDA(dst, b, h) do { _Pragma("unroll") for (int m = 0; m < 4; ++m) _Pragma("unroll") for (int k = 0; k < 2; ++k) dst[m][k] = *(const PG8_LAS bf16x8*)(lds + PG8_SA(b, h) + aoff + m * 2048 + k * 1024); } while (0)
#define PG8_LDB(dst, b, h) do { _Pragma("unroll") for (int n = 0; n < 2; ++n) _Pragma("unroll") for (int k = 0; k < 2; ++k) dst[n][k] = *(const PG8_LAS bf16x8*)(lds + PG8_SB(b, h) + boff + n * 2048 + k * 1024); } while (0)
#define PG8_MMA(ai, bj, At, Bt) do { __builtin_amdgcn_s_setprio(1); _Pragma("unroll") for (int m = 0; m < 4; ++m) _Pragma("unroll") for (int n = 0; n < 2; ++n) _Pragma("unroll") for (int k = 0; k < 2; ++k) \
        acc[ai][bj][m][n] = __builtin_amdgcn_mfma_f32_16x16x32_bf16(Bt[n][k], At[m][k], acc[ai][bj][m][n], 0, 0, 0); __builtin_amdgcn_s_setprio(0); } while (0)
#define PG8_WAIT_V(n) asm volatile("s_waitcnt vmcnt(" #n ")" ::: "memory")
#define PG8_WAIT_L(n) asm volatile("s_waitcnt lgkmcnt(" #n ")" ::: "memory")
#define PG8_BAR __builtin_amdgcn_s_barrier()
#define PG8_SCHED __builtin_amdgcn_sched_barrier(0)
    Unit cur, nxt; int ui = 0;
    if (!S.next(0, cur)) return;
    f32x4 acc[2][2][4][2];
#pragma unroll
    for (int a = 0; a < 2; ++a)
#pragma unroll
        for (int b = 0; b < 2; ++b)
#pragma unroll
            for (int m = 0; m < 4; ++m)
#pragma unroll
                for (int n = 0; n < 2; ++n) acc[a][b][m][n] = (f32x4){0.f, 0.f, 0.f, 0.f};
    bf16x8 At[4][2], B0[2][2], B1[2][2];
    const char* cA = (const char*)g.A + (size_t)cur.pm * tstep; const char* cB = (const char*)g.Bt + (size_t)cur.pn * tstep;
    S.a_ready(cur);
    if constexpr (SP2) {
        PG8_STAGE(PG8_SB(0, 0), cB, voffB); PG8_STAGE(PG8_SB(0, 1), cB + hstep, voffB); PG8_STAGE(PG8_SA(0, 0), cA, voffA); PG8_STAGE(PG8_SA(0, 1), cA + hstep, voffA);
        if (wr == 1) PG8_BAR;
        PG8_WAIT_V(2); PG8_BAR;
        PG8_STAGE(PG8_SB(1, 0), cB + kstep, voffB); PG8_STAGE(PG8_SA(1, 0), cA + kstep, voffA); PG8_STAGE(PG8_SB(1, 1), cB + hstep + kstep, voffB);
        PG8_WAIT_V(6); PG8_BAR;
    } else {
        PG8_STAGE(PG8_SB(0, 0), cB, voffB); PG8_STAGE(PG8_SA(0, 0), cA, voffA); PG8_STAGE(PG8_SB(0, 1), cB + hstep, voffB); PG8_STAGE(PG8_SA(0, 1), cA + hstep, voffA);
        if (wr == 1) PG8_BAR;
        PG8_WAIT_V(4); PG8_BAR;
        PG8_STAGE(PG8_SB(1, 0), cB + kstep, voffB); PG8_STAGE(PG8_SA(1, 0), cA + kstep, voffA); PG8_STAGE(PG8_SB(1, 1), cB + hstep + kstep, voffB);
        PG8_WAIT_V(6); PG8_BAR;
    }
    for (;;) {
        const bool has_next = S.next(ui + 1, nxt);
        const char* nA = has_next ? (const char*)g.A + (size_t)nxt.pm * tstep : cA; const char* nB = has_next ? (const char*)g.Bt + (size_t)nxt.pn * tstep : cB;
        for (int t = 0; t < nt; t += 2) {
            const bool last = (t == nt - 2);
            const char* a1 = cA + (size_t)(t + 1) * kstep;
            const char* a2 = last ? nA : cA + (size_t)(t + 2) * kstep; const char* b2 = last ? nB : cB + (size_t)(t + 2) * kstep;
            const char* a3 = a2 + kstep; const char* b3 = b2 + kstep;
            if (last && has_next) S.a_ready(nxt);
            if constexpr (SP2) {
            PG8_LDB(B0, 0, 0); PG8_LDB(B1, 0, 1); PG8_SCHED; PG8_LDA(At, 0, 0); PG8_STAGE(PG8_SA(1, 1), a1 + hstep, voffA);
            PG8_WAIT_V(8); PG8_WAIT_L(0); PG8_BAR; PG8_MMA(0, 0, At, B0); PG8_MMA(0, 1, At, B1); PG8_BAR; PG8_SCHED;
            PG8_LDA(At, 0, 1); PG8_STAGE(PG8_SB(0, 0), b2, voffB); PG8_STAGE(PG8_SB(0, 1), b2 + hstep, voffB); PG8_STAGE(PG8_SA(0, 0), a2, voffA);
            PG8_WAIT_V(8); PG8_WAIT_L(0); PG8_BAR; PG8_MMA(1, 0, At, B0); PG8_MMA(1, 1, At, B1); PG8_BAR; PG8_SCHED;
            PG8_LDB(B0, 1, 0); PG8_LDB(B1, 1, 1); PG8_SCHED; PG8_LDA(At, 1, 0); PG8_STAGE(PG8_SA(0, 1), a2 + hstep, voffA);
            PG8_WAIT_V(8); PG8_WAIT_L(0); PG8_BAR; PG8_MMA(0, 0, At, B0); PG8_MMA(0, 1, At, B1); PG8_BAR; PG8_SCHED;
            PG8_LDA(At, 1, 1); PG8_STAGE(PG8_SB(1, 0), b3, voffB); PG8_STAGE(PG8_SB(1, 1), b3 + hstep, voffB); PG8_STAGE(PG8_SA(1, 0), a3, voffA);
            PG8_WAIT_V(8); PG8_WAIT_L(0); PG8_BAR; PG8_MMA(1, 0, At, B0); PG8_MMA(1, 1, At, B1); PG8_BAR; PG8_SCHED;
            } else {
            PG8_LDB(B0, 0, 0); PG8_SCHED; PG8_LDA(At, 0, 0); PG8_STAGE(PG8_SA(1, 1), a1 + hstep, voffA);
            PG8_WAIT_L(8); PG8_BAR; PG8_WAIT_L(0); PG8_MMA(0, 0, At, B0); PG8_BAR; PG8_SCHED;
            PG8_LDB(B1, 0, 1); PG8_STAGE(PG8_SB(0, 0), b2, voffB);
            PG8_BAR; PG8_WAIT_L(0); PG8_MMA(0, 1, At, B1); PG8_BAR;
            PG8_LDA(At, 0, 1); PG8_STAGE(PG8_SA(0, 0), a2, voffA);
            PG8_BAR; PG8_WAIT_L(0); PG8_MMA(1, 0, At, B0); PG8_BAR; PG8_SCHED;
            PG8_STAGE(PG8_SB(0, 1), b2 + hstep, voffB);
            PG8_WAIT_V(6); PG8_BAR; PG8_MMA(1, 1, At, B1); PG8_BAR;
            PG8_LDB(B0, 1, 0); PG8_SCHED; PG8_LDA(At, 1, 0); PG8_STAGE(PG8_SA(0, 1), a2 + hstep, voffA);
            PG8_WAIT_L(8); PG8_BAR; PG8_WAIT_L(0); PG8_MMA(0, 0, At, B0); PG8_BAR; PG8_SCHED;
            PG8_LDB(B1, 1, 1); PG8_STAGE(PG8_SB(1, 0), b3, voffB);
            PG8_BAR; PG8_WAIT_L(0); PG8_MMA(0, 1, At, B1); PG8_BAR;
            PG8_LDA(At, 1, 1); PG8_STAGE(PG8_SA(1, 0), a3, voffA);
            PG8_BAR; PG8_WAIT_L(0); PG8_MMA(1, 0, At, B0); PG8_BAR; PG8_SCHED;
            PG8_STAGE(PG8_SB(1, 1), b3 + hstep, voffB);
            PG8_WAIT_V(6); PG8_BAR; PG8_MMA(1, 1, At, B1); PG8_BAR;
            }
        }
        if constexpr (ALIGN_EPI) { if (wr == 0) PG8_BAR; }
        if constexpr (!Epi::AFTER_DRAIN) { E(acc, cur, wr, wc, fr, fq); S.done(cur); }
        if (!has_next) break;
#pragma unroll
        for (int a = 0; a < 2; ++a)
#pragma unroll
            for (int b = 0; b < 2; ++b)
#pragma unroll
                for (int m = 0; m < 4; ++m)
#pragma unroll
                    for (int n = 0; n < 2; ++n) acc[a][b][m][n] = (f32x4){0.f, 0.f, 0.f, 0.f};
        cur = nxt; cA = nA; cB = nB; ++ui;
        if constexpr (ALIGN_EPI) { if (wr == 1) PG8_BAR; }
    }
    PG8_WAIT_V(0);
    if constexpr (!ALIGN_EPI) { if (wr == 0) PG8_BAR; }
    PG8_BAR;
    if constexpr (Epi::AFTER_DRAIN) { E.fused(acc, cur, wr, wc, fr, fq, lds, wid, lane); S.done(cur); }
#undef PG8_SA
#undef PG8_SB
#undef PG8_STAGE
#undef PG8_LDA
#undef PG8_LDB
#undef PG8_MMA
#undef PG8_WAIT_V
#undef PG8_WAIT_L
#undef PG8_BAR
#undef PG8_SCHED
}
}
#define GAS __attribute__((address_space(1)))
#define LAS __attribute__((address_space(3)))
typedef unsigned short bf16;
typedef unsigned v4u __attribute__((ext_vector_type(4)));
typedef float f32x4 __attribute__((ext_vector_type(4)));
typedef short bf16x8 __attribute__((ext_vector_type(8)));
typedef GAS unsigned gu32;
typedef GAS unsigned long long gu64;
#define RLX_AGENT __ATOMIC_RELAXED, __HIP_MEMORY_SCOPE_AGENT
#define LDS_WAIT() asm volatile("s_waitcnt lgkmcnt(0)" ::: "memory")
#define VM_WAIT() asm volatile("s_waitcnt vmcnt(0)" ::: "memory")
__device__ __forceinline__ unsigned long long rt() { return __builtin_amdgcn_s_memrealtime(); }
__device__ __forceinline__ unsigned f2bf(float f) { unsigned u = __builtin_bit_cast(unsigned, f); return (u + 0x7fffu + ((u >> 16) & 1u)) >> 16; }
__device__ __forceinline__ unsigned pk2(float lo, float hi) { return f2bf(lo) | (f2bf(hi) << 16); }

#define XB_TMO      128
#define XB_XCNT(j)  (256  + 64 * (j))
#define XB_XSUB(j)  (1280 + 64 * (j))
#define XB_XGEN(j)  (2304 + 64 * (j))
#define XB_TOP      3328
#define XB_TOPGEN   3392
#define XCD_BAR_WORDS 3456
#define XB_SPIN_CAP (1u << 18)

__device__ __forceinline__ unsigned xb_ld(unsigned* p)              { return __hip_atomic_load(p, __ATOMIC_RELAXED, __HIP_MEMORY_SCOPE_AGENT); }
__device__ __forceinline__ unsigned xb_add(unsigned* p, unsigned v) { return __hip_atomic_fetch_add(p, v, __ATOMIC_RELAXED, __HIP_MEMORY_SCOPE_AGENT); }
__device__ __forceinline__ unsigned xb_xcc_id() { return (unsigned)__builtin_amdgcn_s_getreg((3 << 11) | 20) & 0xFu; }
#define XB_SPIN(cond, bar) do { unsigned _sp = 0; while (cond) { __builtin_amdgcn_s_sleep(1); \
    if ((++_sp & 255u) == 0u) { if (xb_ld(&(bar)[XB_TMO])) break; if (_sp > XB_SPIN_CAP) { atomicAdd(&(bar)[XB_TMO], 1u); break; } } } } while (0)

struct XcdBarrier {
    unsigned* bar; unsigned x;
    volatile LAS unsigned* st;
};

__device__ __forceinline__ XcdBarrier xcd_barrier_post(unsigned* bar, volatile LAS unsigned* st) {
    XcdBarrier b; b.bar = bar; b.x = xb_xcc_id(); b.st = st;
    if (threadIdx.x == 0) st[3] = xb_add(&bar[XB_XCNT(b.x)], 1u);
    return b;
}
__device__ __forceinline__ void xcd_barrier_complete(unsigned* bar, unsigned x, unsigned& nloc, unsigned& nx, unsigned& reg) {
    const unsigned G = gridDim.x * gridDim.y * gridDim.z;
    unsigned sum, cnt, mine, bad, sp = 0u;
    for (;;) {
        sum = 0u; cnt = 0u; mine = 0u; bad = 0u;
#pragma unroll
        for (unsigned j = 0; j < 16; ++j) { const unsigned c = xb_ld(&bar[XB_XCNT(j)]); sum += c; cnt += (c > 0u) ? 1u : 0u; mine = (j == x) ? c : mine; bad += (c != (j < 8u ? 32u : 0u)) ? 1u : 0u; }
        if (sum == G) break;
        __builtin_amdgcn_s_sleep(1);
        if ((++sp & 255u) == 0u) { if (xb_ld(&bar[XB_TMO])) break; if (sp > XB_SPIN_CAP) { atomicAdd(&bar[XB_TMO], 1u); break; } }
    }
    nloc = mine > 0u ? mine : 1u; nx = cnt > 0u ? cnt : 1u; reg = (sum == G && G == 256u && bad == 0u) ? 1u : 0u;
}

__device__ __forceinline__ void xcd_barrier(const XcdBarrier& b) {
    asm volatile("s_waitcnt vmcnt(0)" ::: "memory");
    __syncthreads();
    if (threadIdx.x == 0) {
        unsigned* bar = b.bar; unsigned bx_ = b.x; asm volatile("" : "+s"(bar), "+s"(bx_));
        __builtin_amdgcn_s_waitcnt(0);
        unsigned nloc = b.st[0], nx = b.st[1];
        if (nloc == 0u) { unsigned reg; xcd_barrier_complete(bar, bx_, nloc, nx, reg); b.st[0] = nloc; b.st[1] = nx; b.st[2] = reg; }
        const unsigned old = xb_add(&bar[XB_XSUB(bx_)], 1u);
        const unsigned gen = old / nloc;
        if (old + 1u == (gen + 1u) * nloc) {
            __builtin_amdgcn_fence(__ATOMIC_RELEASE, "agent");
            asm volatile("s_waitcnt vmcnt(0)" ::: "memory");
            const unsigned og = xb_add(&bar[XB_TOP], 1u);
            const unsigned tg = og / nx;
            if (og + 1u == (tg + 1u) * nx) xb_add(&bar[XB_TOPGEN], 1u);
            else XB_SPIN(xb_ld(&bar[XB_TOPGEN]) == tg, bar);
            __builtin_amdgcn_fence(__ATOMIC_ACQUIRE, "agent");
            xb_add(&bar[XB_XGEN(bx_)], 1u);
            asm volatile("s_waitcnt vmcnt(0)" ::: "memory");
        } else {
            XB_SPIN(xb_ld(&bar[XB_XGEN(bx_)]) == gen, bar);
            __builtin_amdgcn_fence(__ATOMIC_ACQUIRE, "agent");
            asm volatile("s_waitcnt vmcnt(0)" ::: "memory");
        }
    }
    __syncthreads();
}

__device__ __forceinline__ void xcd_local_barrier(const XcdBarrier& b) {
    asm volatile("s_waitcnt vmcnt(0)" ::: "memory");
    __syncthreads();
    if (threadIdx.x == 0) {
        unsigned* bar = b.bar; unsigned bx_ = b.x; asm volatile("" : "+s"(bar), "+s"(bx_));
        __builtin_amdgcn_s_waitcnt(0);
        const unsigned nloc = b.st[0];
        const unsigned old = xb_add(&bar[XB_XSUB(bx_)], 1u);
        const unsigned gen = old / nloc;
        if (old + 1u == (gen + 1u) * nloc) xb_add(&bar[XB_XGEN(bx_)], 1u);
        else XB_SPIN(xb_ld(&bar[XB_XGEN(bx_)]) == gen, bar);
        __builtin_amdgcn_fence(__ATOMIC_ACQUIRE, "agent");
        asm volatile("s_waitcnt vmcnt(0)" ::: "memory");
    }
    __syncthreads();
}
constexpr int NWAVES = 8;
constexpr int DM_ = 1024, NBATCH = 8, SEQ_ = 2048, M_ = NBATCH * SEQ_;
constexpr size_t MiB = 1u << 20;
constexpr size_t WS_CTL = 0, CTL_ZERO_BYTES = 32 * 1024;
constexpr size_t WS_W0IN = 2 * MiB, WS_W0OUT = 14 * MiB, WS_W1IN = 18 * MiB, WS_W1OUT = 24 * MiB, WS_W2IN = 27 * MiB, WS_W2OUT = 35 * MiB, WS_W3IN = 37 * MiB, WS_W3OUT = 49 * MiB;
constexpr size_t WS_WF = 53 * MiB;
constexpr size_t WS_WAT = 53 * MiB + 64 * 1024, WS_WXT = WS_WAT + 512 * 1024;
constexpr size_t WS_SSQ = 60 * MiB;
constexpr size_t WS_LOGF = 60 * MiB + 512 * 1024;
constexpr size_t WS_VSSQ = 62 * MiB;
constexpr size_t WS_SUMM = 62 * MiB;
constexpr size_t WS_XB = 64 * MiB;
constexpr size_t WS_ACT = 96 * MiB;
constexpr size_t WS_UG = WS_ACT, WS_GV = WS_ACT + 64 * MiB;
constexpr size_t WS_XBR = WS_ACT, WS_LSG = WS_ACT + 48 * MiB, WS_LY = WS_ACT + 96 * MiB;
constexpr size_t WS_Q = WS_ACT, WS_K = WS_ACT + 32 * MiB, WS_V = WS_ACT + 64 * MiB, WS_FSG = WS_ACT + 96 * MiB;
constexpr size_t ARENA_BYTES = 20 * MiB;
constexpr size_t WS_END = 256 * MiB;
constexpr int CW_BAR = 4096; static_assert((CW_BAR + 3456) * 4 <= (int)CTL_ZERO_BYTES, "barrier words inside the per-call memset");
constexpr int RING_BYTES = 131072, LDSCTL_OFF = RING_BYTES, MISC_OFF = LDSCTL_OFF + 320, LDS_BYTES = 147456;

typedef float f32x16 __attribute__((ext_vector_type(16)));
typedef short s16x4 __attribute__((ext_vector_type(4)));
__device__ __forceinline__ unsigned cvtpk(float lo, float hi) { return pg8::cvt_pk_bf16(lo, hi); }
__device__ __forceinline__ float bflo(unsigned u) { return __uint_as_float(u << 16); }
__device__ __forceinline__ float bfhi(unsigned u) { return __uint_as_float(u & 0xffff0000u); }

#define LDS_BARRIER() do { asm volatile("s_waitcnt lgkmcnt(0)" ::: "memory"); __builtin_amdgcn_s_barrier(); asm volatile("" ::: "memory"); } while (0)

__device__ __forceinline__ void tr_item(const float* W, int K, int ldw, const float* gain, bf16* WT, LAS float* scr, int kb, int nb, int scol, int lane) {
    const int k0 = 64 * kb, n0 = 32 * nb;
    { const int n4 = (lane & 7) * 4, kr = lane >> 3; f32x4 v[8];
#pragma unroll
      for (int i = 0; i < 8; ++i) v[i] = __builtin_nontemporal_load((const f32x4*)(W + (size_t)(k0 + 8 * i + kr) * ldw + scol + n4));
#pragma unroll
      for (int i = 0; i < 8; ++i) { const int kk = 8 * i + kr; const float g = gain ? gain[k0 + kk] : 1.0f; LAS float* d = scr + kk * 33 + n4; d[0] = v[i][0] * g; d[1] = v[i][1] * g; d[2] = v[i][2] * g; d[3] = v[i][3] * g; } }
    LDS_WAIT(); asm volatile("" ::: "memory");
    const int c = lane & 7;
#pragma unroll
    for (int j = 0; j < 4; ++j) { const int n = (lane >> 3) + 8 * j; const LAS float* s = scr + (8 * c) * 33 + n;
        v4u o; o.x = cvtpk(s[0 * 33], s[1 * 33]); o.y = cvtpk(s[2 * 33], s[3 * 33]); o.z = cvtpk(s[4 * 33], s[5 * 33]); o.w = cvtpk(s[6 * 33], s[7 * 33]);
        *(v4u*)(WT + (size_t)(n0 + n) * K + k0 + 8 * c) = o; }
    LDS_WAIT(); asm volatile("" ::: "memory");
}
__device__ __forceinline__ int scol_gmlp(int nb) { const int n = nb * 32, pn = n >> 8, w = n & 255; if (pn < 16) return (w < 128) ? pn * 128 + w : 4096 + pn * 128 + (w - 128); return 2048 + (pn - 16) * 256 + w; }
__device__ __forceinline__ int scol_fox(int nb) { const int n = nb * 32, pn = n >> 8, w = n & 255; if (pn < 8) { const int bj = w >> 7, wc = (w >> 5) & 3; return (pn < 4 ? 0 : 1024) + 64 * (4 * (pn & 3) + wc) + 32 * bj; } return n; }

template <int PART, class A> __device__ __forceinline__ void p0_weights(const A& args, unsigned char* ws, LAS unsigned char* lds, int gw, int NGW, int lane, int wave) {
    LAS float* scr = (LAS float*)(lds + wave * 16384);
    int joff = 0;
#define P0_JOB(Wp, Gp, WTo, K_, LDW_, NBLK_, MAP_) do { const float* W_ = (Wp); const float* G_ = (Gp); bf16* WT_ = (bf16*)(ws + (WTo)); const int nit = ((K_) / 64) * (NBLK_); \
        int it0_ = (gw - joff) % NGW; if (it0_ < 0) it0_ += NGW; joff = (joff + nit) % NGW;     \
        for (int it = it0_; it < nit; it += NGW) { const int kb = it / (NBLK_), nb = it % (NBLK_); const int sc = (MAP_) == 1 ? scol_gmlp(nb) : ((MAP_) == 2 ? scol_fox(nb) : nb * 32); \
            tr_item(W_, (K_), (LDW_), G_, WT_, scr, kb, nb, sc, lane); } } while (0)
    if (PART == 0) {
    P0_JOB(args.in[2], args.in[1], WS_W0IN, 1024, 6144, 192, 1);
    P0_JOB(args.in[6], (const float*)nullptr, WS_W0OUT, 2048, 1024, 32, 0);
    P0_JOB(args.in[8], args.in[7], WS_W1IN, 1024, 3072, 96, 0);
    } else {
    P0_JOB(args.in[16], (const float*)nullptr, WS_W1OUT, 1536, 1024, 32, 0);
    P0_JOB(args.in[18], args.in[17], WS_W2IN, 1024, 4112, 128, 2);
    P0_JOB(args.in[22], (const float*)nullptr, WS_W2OUT, 1024, 1024, 32, 0);
    P0_JOB(args.in[24], args.in[23], WS_W3IN, 1024, 6144, 192, 1);
    P0_JOB(args.in[28], (const float*)nullptr, WS_W3OUT, 2048, 1024, 32, 0);
    }
#undef P0_JOB
    const int gt = gw * 64 + lane, NGT = NGW * 64;
    if (PART == 1) { const float* W = args.in[18]; const float* g = args.in[17]; bf16* WF = (bf16*)(ws + WS_WF);
      for (int i = gt; i < 16 * 1024; i += NGT) { const int hc = i >> 10, k = i & 1023; WF[i] = (bf16)f2bf(g[k] * W[(size_t)k * 4112 + 4096 + hc]); } }
    if (PART == 0) { const float* wa = args.in[11]; const float* wx = args.in[13]; bf16* WAT = (bf16*)(ws + WS_WAT); bf16* WXT = (bf16*)(ws + WS_WXT);
      for (int i = gt; i < 16 * 96 * 96; i += NGT) { const int h = i / 9216, rem = i % 9216, jj = rem / 96, ii = rem % 96; const size_t s = (size_t)h * 9216 + ii * 96 + jj;
          WAT[i] = (bf16)f2bf(wa[s]); WXT[i] = (bf16)f2bf(wx[s]); } }
}
__device__ __forceinline__ void p_prep(const float* x, bf16* XB, float* ssq, int gw, int NGW, int lane) {
    for (int m = gw; m < M_; m += NGW) {
        const f32x4* xr = (const f32x4*)(x + (size_t)m * DM_) + lane; f32x4 v[4]; float s = 0.f;
#pragma unroll
        for (int j = 0; j < 4; ++j) { v[j] = __builtin_nontemporal_load(xr + 64 * j); s += (v[j][0] * v[j][0] + v[j][1] * v[j][1]) + (v[j][2] * v[j][2] + v[j][3] * v[j][3]); }
#pragma unroll
        for (int o = 1; o < 64; o <<= 1) s += __shfl_xor(s, o);
        unsigned long long* o8 = (unsigned long long*)(XB + (size_t)m * DM_) + lane;
#pragma unroll
        for (int j = 0; j < 4; ++j) o8[64 * j] = (unsigned long long)cvtpk(v[j][0], v[j][1]) | ((unsigned long long)cvtpk(v[j][2], v[j][3]) << 32);
        if (lane == 0) *(f32x4*)(ssq + (size_t)m * 4) = (f32x4){s, 0.f, 0.f, 0.f};
    }
}

constexpr int MIX_RS_OFF = RING_BYTES + 512;
struct MixPre { v4u gv[8]; float rs; };
__device__ __forceinline__ void mix_load(MixPre& P, int ch, int g, const bf16* GV, const bf16* UGY, const float* vssq, int tid) {
    const int r0 = ch * 128, c0 = g * 256;
    f32x4 vs[8];
    if (tid < 128) { const f32x4* p = (const f32x4*)(vssq + (size_t)(r0 + tid) * 32);
#pragma unroll
        for (int i = 0; i < 8; ++i) vs[i] = p[i]; }
#pragma unroll
    for (int i = 0; i < 8; ++i) { const int s = (tid >> 5) + 16 * i, cc = tid & 31; P.gv[i] = __builtin_nontemporal_load((const v4u*)(GV + (size_t)(r0 + s) * 2048 + c0 + cc * 8)); }
    P.rs = 0.f;
    if (tid < 128) { float s = 0.f;
#pragma unroll
        for (int i = 0; i < 8; ++i) s += (vs[i][0] + vs[i][1]) + (vs[i][2] + vs[i][3]);
        P.rs = rsqrtf(s * (1.0f / 2048.0f) + 1e-6f); }
}
__device__ __forceinline__ void mix_stage(const MixPre& P, LAS unsigned char* tile, LAS float* RS, int tid) {
    if (tid < 128) RS[tid] = P.rs;
    LDS_BARRIER();
#pragma unroll
    for (int i = 0; i < 8; ++i) { const int s = (tid >> 5) + 16 * i, cc = tid & 31; const float r = RS[s]; const v4u v = P.gv[i]; v4u o;
        o.x = cvtpk(bflo(v.x) * r, bfhi(v.x) * r); o.y = cvtpk(bflo(v.y) * r, bfhi(v.y) * r); o.z = cvtpk(bflo(v.z) * r, bfhi(v.z) * r); o.w = cvtpk(bflo(v.w) * r, bfhi(v.w) * r);
        *(LAS v4u*)(tile + (cc >> 2) * 8192 + s * 64 + (cc & 3) * 16) = o; }
}
__device__ __forceinline__ void mix_compute(const LAS unsigned char* tile, const bf16x8 (&bw)[4][2], const float (&btv)[2], int ch, int g, bf16* UGY, const LAS float* v_norm, int lane, int wid) {
    const int r0 = ch * 128, c0 = g * 256;
    const int tb = wid >> 1, dh = wid & 1, fr = lane & 15, fq = lane >> 4;
    v4u ugv[2][4];
#pragma unroll
    for (int tt = 0; tt < 2; ++tt)
#pragma unroll
        for (int pp = 0; pp < 4; ++pp) ugv[tt][pp] = __builtin_nontemporal_load((const v4u*)(UGY + (size_t)(r0 + 32 * tb + 16 * tt + fr) * 2048 + c0 + 128 * dh + 32 * pp + 8 * fq));
    f32x4 acc[2][4][2];
#pragma unroll
    for (int a = 0; a < 2; ++a)
#pragma unroll
        for (int b = 0; b < 4; ++b)
#pragma unroll
            for (int n = 0; n < 2; ++n) acc[a][b][n] = (f32x4){0.f, 0.f, 0.f, 0.f};
#pragma unroll
    for (int ks = 0; ks < 4; ++ks) { if (ks <= tb) {
        const LAS unsigned char* ab = tile + (4 * dh) * 8192 + (32 * ks + 8 * fq + ((lane & 15) >> 2)) * 64 + (lane & 3) * 16;
#pragma unroll
        for (int pp = 0; pp < 4; ++pp)
#pragma unroll
            for (int n = 0; n < 2; ++n) { const LAS unsigned char* ap = ab + pp * 8192 + n * 8;
                const s16x4 lo = __builtin_bit_cast(s16x4, __builtin_amdgcn_ds_read_tr16_b64_v4i16((LAS s16x4*)ap));
                const s16x4 hi = __builtin_bit_cast(s16x4, __builtin_amdgcn_ds_read_tr16_b64_v4i16((LAS s16x4*)(ap + 4 * 64)));
                const bf16x8 a = (bf16x8){lo[0], lo[1], lo[2], lo[3], hi[0], hi[1], hi[2], hi[3]};
#pragma unroll
                for (int tt = 0; tt < 2; ++tt) acc[tt][pp][n] = __builtin_amdgcn_mfma_f32_16x16x32_bf16(a, bw[ks][tt], acc[tt][pp][n], 0, 0, 0); }
    } }
#pragma unroll
    for (int tt = 0; tt < 2; ++tt) { const int tl = 32 * tb + 16 * tt + fr; const float bt = btv[tt];
#pragma unroll
        for (int pp = 0; pp < 4; ++pp) { const int col = c0 + 128 * dh + 32 * pp + 8 * fq; bf16* p = UGY + (size_t)(r0 + tl) * 2048 + col;
            const v4u ug = ugv[tt][pp]; const f32x4 n0 = *(const LAS f32x4*)(v_norm + col), n1 = *(const LAS f32x4*)(v_norm + col + 4);
            const f32x4 a0 = acc[tt][pp][0], a1 = acc[tt][pp][1]; v4u o;
            o.x = cvtpk(bflo(ug.x) * (n0[0] * a0[0] + bt), bfhi(ug.x) * (n0[1] * a0[1] + bt)); o.y = cvtpk(bflo(ug.y) * (n0[2] * a0[2] + bt), bfhi(ug.y) * (n0[3] * a0[3] + bt));
            o.z = cvtpk(bflo(ug.z) * (n1[0] * a1[0] + bt), bfhi(ug.z) * (n1[1] * a1[1] + bt)); o.w = cvtpk(bflo(ug.w) * (n1[2] * a1[2] + bt), bfhi(ug.w) * (n1[3] * a1[3] + bt));
            *(v4u*)p = o; } }
}
__device__ __forceinline__ void mix_phase(LAS unsigned char* lds, int k, int g, int n, const bf16* GV, bf16* UGY, const float* vssq, const float* w_s, const float* b_s, const float* v_norm, int tid, int lane, int wid) {
    LAS float* RS = (LAS float*)(lds + MIX_RS_OFF); LAS float* VN = (LAS float*)(lds + MIX_RS_OFF + 1024);
    *(LAS f32x4*)(VN + 4 * tid) = *(const f32x4*)(v_norm + 4 * tid);
    const int tb = wid >> 1, fr = lane & 15, fq = lane >> 4;
    MixPre P;

    if (n > 0) mix_load(P, 4 * k, g, GV, UGY, vssq, tid);
    bf16x8 bw[4][2]; float btv[2];
    { f32x4 wv[4][2][2];
#pragma unroll
      for (int tt = 0; tt < 2; ++tt) { const int t = 32 * tb + 16 * tt + fr; btv[tt] = b_s[g * 128 + t];
#pragma unroll
        for (int ks = 0; ks < 4; ++ks) { const float* wp = w_s + ((size_t)g * 128 + t) * 128 + 32 * ks + 8 * fq;
            if (ks <= tb) { wv[ks][tt][0] = *(const f32x4*)wp; wv[ks][tt][1] = *(const f32x4*)(wp + 4); } else { wv[ks][tt][0] = (f32x4){0.f, 0.f, 0.f, 0.f}; wv[ks][tt][1] = (f32x4){0.f, 0.f, 0.f, 0.f}; } } }
#pragma unroll
      for (int ks = 0; ks < 4; ++ks) { const int s0 = 32 * ks + 8 * fq;
#pragma unroll
        for (int tt = 0; tt < 2; ++tt) { const int t = 32 * tb + 16 * tt + fr; const f32x4 w0 = wv[ks][tt][0], w1 = wv[ks][tt][1]; float e[8];
#pragma unroll
            for (int j = 0; j < 4; ++j) { e[j] = (s0 + j <= t) ? w0[j] : 0.f; e[4 + j] = (s0 + 4 + j <= t) ? w1[j] : 0.f; }
            v4u pk; pk.x = cvtpk(e[0], e[1]); pk.y = cvtpk(e[2], e[3]); pk.z = cvtpk(e[4], e[5]); pk.w = cvtpk(e[6], e[7]);
            bw[ks][tt] = __builtin_bit_cast(bf16x8, pk); } } }
    if (n > 0) mix_stage(P, lds, RS, tid);
    LDS_BARRIER();

    for (int i = 0; i < n; ++i) { const int buf = i & 1;

        if (i + 1 < n) mix_load(P, 4 * k + i + 1, g, GV, UGY, vssq, tid);

        mix_compute(lds + buf * 65536, bw, btv, 4 * k + i, g, UGY, VN, lane, wid);

        if (i + 1 < n) mix_stage(P, lds + (buf ^ 1) * 65536, RS, tid);

        LDS_BARRIER(); }
}

__device__ __forceinline__ void mix_phase_w(LAS unsigned char* lds, int ch0, int g, int n, const bf16* GV, bf16* UGY, const float* vssq, const float* w_s, const float* b_s, const float* v_norm, int tid, int lane, int wid) {
    LAS float* RS = (LAS float*)(lds + MIX_RS_OFF);
    { const int it = tid >> 7, s = tid & 127;
      if (it < n) { const f32x4* p = (const f32x4*)(vssq + (size_t)((ch0 + it) * 128 + s) * 32); float sum = 0.f;
#pragma unroll
        for (int i = 0; i < 8; ++i) { const f32x4 v = p[i]; sum += (v[0] + v[1]) + (v[2] + v[3]); }
        RS[tid] = rsqrtf(sum * (1.0f / 2048.0f) + 1e-6f); } }
    const int fr = lane & 15, fq = lane >> 4, cw = g * 256 + 32 * wid;
    LAS unsigned char* WL = lds + 65536;
    { const int t = tid >> 2, sb = (tid & 3) * 32; const float* wp = w_s + ((size_t)g * 128 + t) * 128 + sb;
#pragma unroll
      for (int q = 0; q < 4; ++q) { const f32x4 w0 = *(const f32x4*)(wp + 8 * q), w1 = *(const f32x4*)(wp + 8 * q + 4); const int s0 = sb + 8 * q; float e[8];
#pragma unroll
        for (int z = 0; z < 4; ++z) { e[z] = (s0 + z <= t) ? w0[z] : 0.f; e[4 + z] = (s0 + 4 + z <= t) ? w1[z] : 0.f; }
        v4u pk; pk.x = cvtpk(e[0], e[1]); pk.y = cvtpk(e[2], e[3]); pk.z = cvtpk(e[4], e[5]); pk.w = cvtpk(e[6], e[7]);
        *(LAS v4u*)(WL + t * 272 + (s0 * 2)) = pk; } }
    float btv[8];
#pragma unroll
    for (int jj = 0; jj < 8; ++jj) btv[jj] = b_s[g * 128 + 16 * jj + fr];
    const f32x4 n0 = *(const f32x4*)(v_norm + cw + 8 * fq), n1 = *(const f32x4*)(v_norm + cw + 8 * fq + 4);
    LDS_BARRIER();
    LAS unsigned char* tile = lds + wid * 8192;
    v4u gvv[8];
#define MIXW_LOADGV(i_) do { const int rr_ = (ch0 + ((i_) < n ? (i_) : n - 1)) * 128; _Pragma("unroll") for (int k = 0; k < 8; ++k) gvv[k] = *(const v4u*)(GV + (size_t)(rr_ + (lane >> 2) + 16 * k) * 2048 + cw + 8 * (lane & 3)); } while (0)
    MIXW_LOADGV(0);
#pragma unroll 1
    for (int i = 0; i < n; ++i) { const int r0 = (ch0 + i) * 128;
        v4u ugv[8];
#pragma unroll
        for (int j = 0; j < 8; ++j) ugv[j] = *(const v4u*)(UGY + (size_t)(r0 + 16 * j + fr) * 2048 + cw + 8 * fq);
#pragma unroll
        for (int k = 0; k < 8; ++k) { const int s = (lane >> 2) + 16 * k; const float r = RS[i * 128 + s]; const v4u v = gvv[k]; v4u o;
            o.x = cvtpk(bflo(v.x) * r, bfhi(v.x) * r); o.y = cvtpk(bflo(v.y) * r, bfhi(v.y) * r); o.z = cvtpk(bflo(v.z) * r, bfhi(v.z) * r); o.w = cvtpk(bflo(v.w) * r, bfhi(v.w) * r);
            *(LAS v4u*)(tile + s * 64 + (lane & 3) * 16) = o; }
        MIXW_LOADGV(i + 1);
        f32x4 acc[8][2];
#pragma unroll
        for (int j = 0; j < 8; ++j) { acc[j][0] = (f32x4){0.f, 0.f, 0.f, 0.f}; acc[j][1] = (f32x4){0.f, 0.f, 0.f, 0.f}; }
#pragma unroll
        for (int ks = 0; ks < 4; ++ks) { const LAS unsigned char* ab = tile + (32 * ks + 8 * fq + (fr >> 2)) * 64 + (lane & 3) * 16; bf16x8 a[2];
#pragma unroll
            for (int nn = 0; nn < 2; ++nn) { const LAS unsigned char* ap = ab + nn * 8;
                const s16x4 lo = __builtin_bit_cast(s16x4, __builtin_amdgcn_ds_read_tr16_b64_v4i16((LAS s16x4*)ap));
                const s16x4 hi = __builtin_bit_cast(s16x4, __builtin_amdgcn_ds_read_tr16_b64_v4i16((LAS s16x4*)(ap + 4 * 64)));
                a[nn] = (bf16x8){lo[0], lo[1], lo[2], lo[3], hi[0], hi[1], hi[2], hi[3]}; }
#pragma unroll
            for (int j = 2 * ks; j < 8; ++j) { const bf16x8 b = *(const LAS bf16x8*)(WL + (16 * j + fr) * 272 + (32 * ks + 8 * fq) * 2);
                acc[j][0] = __builtin_amdgcn_mfma_f32_16x16x32_bf16(a[0], b, acc[j][0], 0, 0, 0); acc[j][1] = __builtin_amdgcn_mfma_f32_16x16x32_bf16(a[1], b, acc[j][1], 0, 0, 0); } }
#pragma unroll
        for (int j = 0; j < 8; ++j) { const float bt = btv[j]; bf16* p = UGY + (size_t)(r0 + 16 * j + fr) * 2048 + cw + 8 * fq; const v4u ug = ugv[j]; const f32x4 a0 = acc[j][0], a1 = acc[j][1]; v4u o;
            o.x = cvtpk(bflo(ug.x) * (n0[0] * a0[0] + bt), bfhi(ug.x) * (n0[1] * a0[1] + bt)); o.y = cvtpk(bflo(ug.y) * (n0[2] * a0[2] + bt), bfhi(ug.y) * (n0[3] * a0[3] + bt));
            o.z = cvtpk(bflo(ug.z) * (n1[0] * a1[0] + bt), bfhi(ug.z) * (n1[1] * a1[1] + bt)); o.w = cvtpk(bflo(ug.w) * (n1[2] * a1[2] + bt), bfhi(ug.w) * (n1[3] * a1[3] + bt));
            *(v4u*)p = o; }
    }
#undef MIXW_LOADGV
}

constexpr int RSTD_TAB_OFF = RING_BYTES + 1024;
template <class Sched> __device__ __forceinline__ void rstd_table(LAS unsigned char* lds, const Sched& S, const float* ssq, int tid) {
    LAS float* RT = (LAS float*)(lds + RSTD_TAB_OFF); pg8::Unit u;
    for (int i = 0; S.next(i, u); ++i) if (tid < 256) RT[i * 256 + tid] = pg8::row_rstd(ssq, u.pm * 256 + tid);
    __syncthreads();
}

__device__ __forceinline__ void flogit_phase(const bf16* XB, const bf16* WF, const float* ssq, const float* b_f, float* LOGF, int vcu, int G, int wid, int lane) {
    if (wid >= 4) return;
    for (int tile = vcu * 4 + wid; tile < M_ / 16; tile += G * 4) {
        const int row0 = tile * 16; f32x4 acc = (f32x4){0.f, 0.f, 0.f, 0.f};
        const bf16* ap = XB + (size_t)(row0 + (lane & 15)) * 1024 + 8 * (lane >> 4); const bf16* bp = WF + (size_t)(lane & 15) * 1024 + 8 * (lane >> 4);
#pragma unroll
        for (int kk = 0; kk < 32; ++kk) { const bf16x8 a = *(const bf16x8*)(ap + 32 * kk), b = *(const bf16x8*)(bp + 32 * kk); acc = __builtin_amdgcn_mfma_f32_16x16x32_bf16(a, b, acc, 0, 0, 0); }
        const float bf = b_f[lane & 15]; f32x4 lf4;
#pragma unroll
        for (int r = 0; r < 4; ++r) { const int row = row0 + 4 * (lane >> 4) + r; const float x = acc[r] * pg8::row_rstd(ssq, row) + bf;
            lf4[r] = fminf(x, 0.f) - 0.69314718056f * __builtin_amdgcn_logf(1.0f + __builtin_amdgcn_exp2f(-1.4426950409f * fabsf(x))); }
        { const int row = row0 + 4 * (lane >> 4); *(f32x4*)(LOGF + ((size_t)(row >> 11) * 16 + (lane & 15)) * 2048 + (row & 2047)) = lf4; }
    }
}
constexpr int L_XS = 0, L_STG = 0, L_XC = 49728, L_CW = 102976, L_WSUM = 104896, L_HIN = 107968, L_WB = 108416, L_RS = 208;
__device__ __forceinline__ void lru_item(LAS unsigned char* lds, int b, int h, int hf, const bf16* XBR, const bf16* SG, bf16* Y, const bf16* WAT, const bf16* WXT,
                                         const float* conv_w, const float* conv_b, const float* b_a, const float* b_x, const float* lam, int tid, int lane, int wid) {
    const size_t rowb = (size_t)b * SEQ_;
    const int c16 = lane & 15, fq = lane >> 4;
    for (int i = tid; i < 480; i += 512) { const int w = i / 96, cch = i % 96; ((LAS float*)(lds + L_CW))[i] = (w < 4) ? conv_w[w * 1536 + h * 96 + cch] : conv_b[h * 96 + cch]; }
    if (tid < 96) ((LAS float*)(lds + L_HIN))[tid] = 0.f;
    for (int p = tid; p < 1152; p += 512) { const int mat = p / 576, rem = p % 576, row = rem / 12, cc = rem % 12;
        *(LAS v4u*)(lds + L_WB + (mat * 48 + row) * L_RS + cc * 16) = *(const v4u*)((mat ? WXT : WAT) + ((size_t)h * 96 + 48 * hf + row) * 96 + cc * 8); }
    float cbA[3], cbX[3], c8l[3];
#pragma unroll
    for (int nt = 0; nt < 3; ++nt) { const int ch = h * 96 + 48 * hf + 16 * nt + c16;
        cbA[nt] = -1.4426950409f * b_a[ch]; cbX[nt] = -1.4426950409f * b_x[ch]; c8l[nt] = -8.0f * 1.4426950409f * log1pf(__expf(-lam[ch])); }
    v4u xs[10], sgr[3];
#define LRU_LOADX(tl_, tid_) do { const int tc_ = (tid_) < 444 ? (tid_) : 443; const int c_ = tc_ % 12, tg_ = tc_ / 12; _Pragma("unroll") for (int i = 0; i < 10; ++i) { int tok = (tl_) * 256 - 3 + 7 * tg_ + i; tok = tok < 0 ? 0 : (tok > 2047 ? 2047 : tok); \
        xs[i] = *(const v4u*)(XBR + (rowb + tok) * 1536 + h * 96 + 8 * c_); } } while (0)
    LRU_LOADX(0, tid);
    LDS_BARRIER();
#pragma unroll 1
    for (int tl = 0; tl < 8; ++tl) {
        const int t0 = tl * 256; int tq = tid; asm volatile("" : "+v"(tq));
        if (tq < 444) { const int c = tq % 12, tg = tq / 12; const LAS float* cw = (const LAS float*)(lds + L_CW) + 8 * c;
            if (tl == 0 && tg == 0) { xs[0] = (v4u){0u, 0u, 0u, 0u}; xs[1] = (v4u){0u, 0u, 0u, 0u}; xs[2] = (v4u){0u, 0u, 0u, 0u}; }
            typedef float f32x2_ __attribute__((ext_vector_type(2)));
            f32x2_ wv[4][4], bv[4];
#pragma unroll
            for (int w = 0; w < 4; ++w) { const f32x4 w0 = *(const LAS f32x4*)(cw + 96 * w), w1 = *(const LAS f32x4*)(cw + 96 * w + 4);
                wv[w][0] = (f32x2_){w0[0], w0[1]}; wv[w][1] = (f32x2_){w0[2], w0[3]}; wv[w][2] = (f32x2_){w1[0], w1[1]}; wv[w][3] = (f32x2_){w1[2], w1[3]}; }
            { const f32x4 b0 = *(const LAS f32x4*)(cw + 384), b1 = *(const LAS f32x4*)(cw + 388); bv[0] = (f32x2_){b0[0], b0[1]}; bv[1] = (f32x2_){b0[2], b0[3]}; bv[2] = (f32x2_){b1[0], b1[1]}; bv[3] = (f32x2_){b1[2], b1[3]}; }
            f32x2_ ux[10][4];
#pragma unroll
            for (int r = 0; r < 10; ++r) { const v4u xv = xs[r]; ux[r][0] = (f32x2_){bflo(xv.x), bfhi(xv.x)}; ux[r][1] = (f32x2_){bflo(xv.y), bfhi(xv.y)}; ux[r][2] = (f32x2_){bflo(xv.z), bfhi(xv.z)}; ux[r][3] = (f32x2_){bflo(xv.w), bfhi(xv.w)}; }
#pragma unroll
            for (int k = 0; k < 7; ++k) { const int t = 7 * tg + k;
                if (t < 256) { f32x2_ a[4] = {bv[0], bv[1], bv[2], bv[3]};
#pragma unroll
                    for (int w = 0; w < 4; ++w)
#pragma unroll
                        for (int p = 0; p < 4; ++p) a[p] = __builtin_elementwise_fma(wv[w][p], ux[k + w][p], a[p]);
                    v4u o; o.x = cvtpk(a[0][0], a[0][1]); o.y = cvtpk(a[1][0], a[1][1]); o.z = cvtpk(a[2][0], a[2][1]); o.w = cvtpk(a[3][0], a[3][1]);
                    *(LAS v4u*)(lds + L_XC + t * L_RS + c * 16) = o; } } }
        LDS_BARRIER();
        if (tl < 7) LRU_LOADX(tl + 1, tq);
#pragma unroll
        for (int i = 0; i < 3; ++i) { const int p = tq + 512 * i, t = p / 6, c6 = p % 6; sgr[i] = __builtin_nontemporal_load((const v4u*)(SG + (rowb + t0 + t) * 1536 + h * 96 + 48 * hf + 8 * c6)); }
        f32x4 accA[2][3], accX[2][3];
#pragma unroll
        for (int mt = 0; mt < 2; ++mt)
#pragma unroll
            for (int nt = 0; nt < 3; ++nt) { accA[mt][nt] = (f32x4){0.f, 0.f, 0.f, 0.f}; accX[mt][nt] = (f32x4){0.f, 0.f, 0.f, 0.f}; }
#pragma unroll
        for (int mt = 0; mt < 2; ++mt)
#pragma unroll
            for (int ks = 0; ks < 3; ++ks) { const bf16x8 a = *(const LAS bf16x8*)(lds + L_XC + (32 * wid + 16 * mt + c16) * L_RS + (32 * ks + 8 * fq) * 2);
#pragma unroll
                for (int nt = 0; nt < 3; ++nt) { const bf16x8 ba = *(const LAS bf16x8*)(lds + L_WB + (16 * nt + c16) * L_RS + (32 * ks + 8 * fq) * 2), bx = *(const LAS bf16x8*)(lds + L_WB + (48 + 16 * nt + c16) * L_RS + (32 * ks + 8 * fq) * 2);
                    accA[mt][nt] = __builtin_amdgcn_mfma_f32_16x16x32_bf16(a, ba, accA[mt][nt], 0, 0, 0); accX[mt][nt] = __builtin_amdgcn_mfma_f32_16x16x32_bf16(a, bx, accX[mt][nt], 0, 0, 0); } }
        float carP[3][2] = {{1.f, 1.f}, {1.f, 1.f}, {1.f, 1.f}}, carH[3][2] = {{0.f, 0.f}, {0.f, 0.f}, {0.f, 0.f}};
#pragma unroll
        for (int nt = 0; nt < 3; ++nt) {
            float Pg[2], Hg[2];
#pragma unroll
            for (int mt = 0; mt < 2; ++mt) {
#pragma unroll
                for (int r = 0; r < 4; ++r) { const int tloc = 32 * wid + 16 * mt + 4 * fq + r;
                    const float xcv = __uint_as_float((unsigned)(*(const LAS unsigned short*)(lds + L_XC + tloc * L_RS + (48 * hf + 16 * nt + c16) * 2)) << 16);
                    const float rg = __builtin_amdgcn_rcpf(1.0f + __builtin_amdgcn_exp2f(fmaf(accA[mt][nt][r], -1.4426950409f, cbA[nt])));
                    const float ig = __builtin_amdgcn_rcpf(1.0f + __builtin_amdgcn_exp2f(fmaf(accX[mt][nt][r], -1.4426950409f, cbX[nt])));
                    const float a = __builtin_amdgcn_exp2f(rg * c8l[nt]);
                    accA[mt][nt][r] = a; accX[mt][nt][r] = __builtin_amdgcn_sqrtf(fmaf(-a, a, 1.0f)) * (ig * xcv); }
                const float a0 = accA[mt][nt][0], a1 = accA[mt][nt][1], a2 = accA[mt][nt][2], a3 = accA[mt][nt][3];
                Pg[mt] = (a0 * a1) * (a2 * a3); Hg[mt] = ((accX[mt][nt][0] * a1 + accX[mt][nt][1]) * a2 + accX[mt][nt][2]) * a3 + accX[mt][nt][3]; }
            float cP = 1.0f, cH = 0.0f;
#pragma unroll
            for (int mt = 0; mt < 2; ++mt)
#pragma unroll
                for (int k = 0; k < 4; ++k) { const float P = __shfl(Pg[mt], c16 + 16 * k), H = __shfl(Hg[mt], c16 + 16 * k);
                    if (k == fq) { carP[nt][mt] = cP; carH[nt][mt] = cH; }
                    cP = cP * P; cH = cH * P + H; }
            if (fq == 0) { LAS float* ws = (LAS float*)(lds + L_WSUM) + (wid * 48 + 16 * nt + c16) * 2; ws[0] = cP; ws[1] = cH; }
        }
        LDS_BARRIER();
        {   const LAS float* hinb = (const LAS float*)(lds + L_HIN) + (tl & 1) * 48; LAS float* hout = (LAS float*)(lds + L_HIN) + ((tl & 1) ^ 1) * 48; LAS float* stg = (LAS float*)(lds + L_STG);
#pragma unroll
            for (int nt = 0; nt < 3; ++nt) { const int j = 16 * nt + c16; float hin = hinb[j];
                float sP[8], sH[8];
#pragma unroll
                for (int v = 0; v < 8; ++v) { const LAS float* ws = (const LAS float*)(lds + L_WSUM) + (v * 48 + j) * 2; sP[v] = ws[0]; sH[v] = ws[1]; }
#pragma unroll
                for (int v = 0; v < 8; ++v) { const float hn = hin * sP[v] + sH[v]; if (v == 7) { if (wid == 7 && fq == 0) hout[j] = hn; } else if (v < wid) hin = hn; }
#pragma unroll
                for (int mt = 0; mt < 2; ++mt) { float hs = hin * carP[nt][mt] + carH[nt][mt];
#pragma unroll
                    for (int r = 0; r < 4; ++r) { hs = accA[mt][nt][r] * hs + accX[mt][nt][r]; stg[(32 * wid + 16 * mt + 4 * fq + r) * 48 + j] = hs; } } }
        }
        LDS_BARRIER();
#pragma unroll
        for (int i = 0; i < 3; ++i) { const int p = tq + 512 * i, t = p / 6, c6 = p % 6; const LAS float* sp = (const LAS float*)(lds + L_STG) + t * 48 + 8 * c6;
            const f32x4 h0 = *(const LAS f32x4*)sp, h1 = *(const LAS f32x4*)(sp + 4); const v4u g = sgr[i]; v4u o;
            o.x = cvtpk(h0[0] * bflo(g.x), h0[1] * bfhi(g.x)); o.y = cvtpk(h0[2] * bflo(g.y), h0[3] * bfhi(g.y)); o.z = cvtpk(h1[0] * bflo(g.z), h1[1] * bfhi(g.z)); o.w = cvtpk(h1[2] * bflo(g.w), h1[3] * bfhi(g.w));
            *(v4u*)(Y + (rowb + t0 + t) * 1536 + h * 96 + 48 * hf + 8 * c6) = o; }
    }
#undef LRU_LOADX
}
#include <hip/hip_bf16.h>
namespace attn_body {
using bf16x8=__attribute__((ext_vector_type(8)))short;
using s16x4=__attribute__((ext_vector_type(4)))short;
using f32x16=__attribute__((ext_vector_type(16)))float;
using f32x4=__attribute__((ext_vector_type(4)))float;
using u32x4=__attribute__((ext_vector_type(4)))unsigned;
typedef unsigned short bf16;
constexpr int NHEAD=16,SEQ=2048,D=64,DM=NHEAD*D;
constexpr int NW=8,QBLK=32,QB=QBLK*NW,KVBLK=64,NQB=SEQ/QB;
__device__ __forceinline__ int crow(int r,int hi){return (r&3)+8*(r>>2)+4*hi;}
#define SBAR() __builtin_amdgcn_sched_barrier(0)
__device__ __forceinline__ void cmask(f32x16&p0,f32x16&p1,int jb,int qrel,int hi){
  const float NEG=-INFINITY; int kb=64*jb+4*hi;
  #pragma unroll
  for(int r=0;r<16;++r){int kv=kb+(r&3)+8*(r>>2); if(kv>qrel)p0[r]=NEG; if(kv+32>qrel)p1[r]=NEG;}
}
constexpr int NSLOT=3, SLOTB=8192;
constexpr int LDS_K=0, LDS_V=NSLOT*SLOTB, LDS_WS=2*NSLOT*SLOTB, LDS_OST=LDS_WS+NW*64*4, LDS_BT=LDS_OST+NW*8192, LDS_CUM=LDS_BT+NW*256, LDS_BYTES=LDS_CUM+SEQ*4;
constexpr float C2=0.125f*1.4426950408889634f;
__device__ __forceinline__ void glds16(const void*gsrc,unsigned lds_dst){unsigned keep;
  asm volatile("s_mov_b32 %0, m0\n\ts_mov_b32 m0, %2\n\ts_nop 0\n\tglobal_load_lds_dwordx4 %1, off\n\ts_mov_b32 m0, %0":"=&s"(keep):"v"(gsrc),"s"(lds_dst):"memory");}
typedef float f32x2_t __attribute__((ext_vector_type(2))); typedef __bf16 bf16x2_t __attribute__((ext_vector_type(2)));
__device__ __forceinline__ unsigned cvtpk_s(float lo,float hi){f32x2_t v={lo,hi};bf16x2_t b=__builtin_convertvector(v,bf16x2_t);return __builtin_bit_cast(unsigned,b);}
#define WAIT_BAR(N) asm volatile("s_waitcnt vmcnt(" #N ") lgkmcnt(0)\n\ts_barrier":::"memory")
typedef __attribute__((address_space(3))) const char* lds_cptr;
typedef __attribute__((address_space(3))) const float* lds_fptr;
typedef short v4i16_t __attribute__((ext_vector_type(4)));
typedef __attribute__((address_space(3))) float* lds_wfptr;
__device__ __forceinline__ void bias_init(f32x16&c0,f32x16&c1,lds_fptr cum,lds_wfptr bt,int t,int lane,int hi,float cwm){
  bt[lane]=cwm-cum[64*t+lane];
  const __attribute__((address_space(3))) f32x4* bp=(const __attribute__((address_space(3))) f32x4*)(bt+4*hi);
  #pragma unroll
  for(int g=0;g<4;++g){ const f32x4 a=bp[2*g]; const f32x4 b=bp[8+2*g];
    #pragma unroll
    for(int i=0;i<4;++i){ c0[4*g+i]=a[i]; c1[4*g+i]=b[i]; } }
}
__device__ __forceinline__ void qkt(f32x16&p0,f32x16&p1,const char*Kslot,const bf16x8*qr,int r32,int hi){
  const char*kb=Kslot+hi*1024+r32*16;
  #pragma unroll
  for(int d0=0;d0<4;++d0){
    const bf16x8 b0=*reinterpret_cast<const bf16x8*>(kb+d0*2048);
    const bf16x8 b1=*reinterpret_cast<const bf16x8*>(kb+d0*2048+512);
    p0=__builtin_amdgcn_mfma_f32_32x32x16_bf16(b0,qr[d0],p0,0,0,0);p1=__builtin_amdgcn_mfma_f32_32x32x16_bf16(b1,qr[d0],p1,0,0,0);}
}
__device__ __forceinline__ void kload8(bf16x8*kf,lds_cptr kp){
  kf[0]=*(const __attribute__((address_space(3))) bf16x8*)(kp);      kf[1]=*(const __attribute__((address_space(3))) bf16x8*)(kp+512);
  kf[2]=*(const __attribute__((address_space(3))) bf16x8*)(kp+2048); kf[3]=*(const __attribute__((address_space(3))) bf16x8*)(kp+2560);
  kf[4]=*(const __attribute__((address_space(3))) bf16x8*)(kp+4096); kf[5]=*(const __attribute__((address_space(3))) bf16x8*)(kp+4608);
  kf[6]=*(const __attribute__((address_space(3))) bf16x8*)(kp+6144); kf[7]=*(const __attribute__((address_space(3))) bf16x8*)(kp+6656);
}
__device__ __forceinline__ void kload2(bf16x8*kf,lds_cptr kp,int j){ kf[2*j]=*(const __attribute__((address_space(3))) bf16x8*)(kp+j*2048); kf[2*j+1]=*(const __attribute__((address_space(3))) bf16x8*)(kp+j*2048+512); }
__device__ __forceinline__ s16x4 vtr(lds_cptr p){ return __builtin_bit_cast(s16x4,__builtin_amdgcn_ds_read_tr16_b64_v4i16((__attribute__((address_space(3))) v4i16_t*)p)); }
__device__ __forceinline__ void pv(f32x16*o,int vb,bf16x8 pa0,bf16x8 pa1,bf16x8 pa2,bf16x8 pa3){
  #pragma unroll
  for(int d0=0;d0<2;++d0){s16x4 lo[4],hi[4];
    #pragma unroll
    for(int ks=0;ks<4;++ks){
      asm volatile("ds_read_b64_tr_b16 %0,%1 offset:%c2":"=&v"(lo[ks]):"v"(vb),"i"(d0*4096+ks*1024):"memory");
      asm volatile("ds_read_b64_tr_b16 %0,%1 offset:%c2":"=&v"(hi[ks]):"v"(vb),"i"(d0*4096+ks*1024+512):"memory");}
    asm volatile("s_waitcnt lgkmcnt(0)":::"memory");SBAR();
    #define PK(k) (bf16x8){lo[k][0],lo[k][1],lo[k][2],lo[k][3],hi[k][0],hi[k][1],hi[k][2],hi[k][3]}
    o[d0]=__builtin_amdgcn_mfma_f32_32x32x16_bf16(pa0,PK(0),o[d0],0,0,0);
    o[d0]=__builtin_amdgcn_mfma_f32_32x32x16_bf16(pa1,PK(1),o[d0],0,0,0);
    o[d0]=__builtin_amdgcn_mfma_f32_32x32x16_bf16(pa2,PK(2),o[d0],0,0,0);
    o[d0]=__builtin_amdgcn_mfma_f32_32x32x16_bf16(pa3,PK(3),o[d0],0,0,0);
    #undef PK
  }
}
__device__ __forceinline__ void attn_unit(int b,int h,int qb,const bf16*Q,const bf16*__restrict__ K,const bf16*__restrict__ V,const bf16*__restrict__ SG,bf16*O,char*shm,float mref,bf16x8 (&qr)[4],bool pre,int qb_next){
  int tid_=threadIdx.x; asm volatile("":"+v"(tid_)); const int tid=tid_,lane=tid&63,r32=lane&31,hi=lane>>5; const int wid=__builtin_amdgcn_readfirstlane(tid>>6);
  const long rowbase=(long)b*SEQ; const int q0=qb*QB;
  const bf16*Qw=Q+(rowbase+q0+wid*QBLK)*DM+h*D;
  const bf16*Kh=K+rowbase*DM+h*D,*Vh=V+rowbase*DM+h*D;
  const unsigned lds0=(unsigned)(uintptr_t)shm;
  const bf16*ksrc=Kh+(long)lane*DM+wid*8;
  const bf16*vsrc=Vh+(long)(16*(wid&3)+(lane>>2))*DM+(wid>>2)*32+(lane&3)*8;
  const unsigned kdst=lds0+LDS_K+wid*1024, vdst=lds0+LDS_V+wid*1024;
  #define DMA_K(t,slot) glds16(ksrc+(long)(t)*KVBLK*DM,(unsigned)__builtin_amdgcn_readfirstlane(kdst+(slot)))
  #define DMA_V(t,slot) glds16(vsrc+(long)(t)*KVBLK*DM,(unsigned)__builtin_amdgcn_readfirstlane(vdst+(slot)))
  const int vb0=(int)(lds0+LDS_V)+((lane>>4)&1)*32+(lane&3)*8+(4*hi+((lane&15)>>2))*64;
  const char*Kbase=shm+LDS_K; bf16x8 kf[8];
  const lds_cptr shm3=(lds_cptr)shm; const lds_cptr kp0=shm3+LDS_K+hi*1024+r32*16; const lds_cptr vp0=shm3+LDS_V+((lane>>4)&1)*32+(lane&3)*8+(4*hi+((lane&15)>>2))*64;
  const lds_fptr cum=(lds_fptr)(shm3+LDS_CUM);
  const int NT=(q0+QB)/KVBLK;
  if(!pre){ DMA_K(0,0);DMA_V(0,0);DMA_K(1,SLOTB);
  #pragma unroll
  for(int d0=0;d0<4;++d0)qr[d0]=*reinterpret_cast<const bf16x8*>(&Qw[(long)r32*DM+d0*16+hi*8]); }
  float l_reg=0.f;f32x16 o[2];o[0]=f32x16{};o[1]=f32x16{};
  const int qrel=wid*QBLK+r32;
  const float cwm=cum[q0+wid*QBLK+QBLK-1]-mref; const lds_wfptr bt=(lds_wfptr)(__attribute__((address_space(3))) char*)(shm3+LDS_BT)+wid*64;
  #define CMASK(P0,P1,t) do{int jb_=(t)-(NT-4); if(jb_>=0)cmask(P0,P1,jb_,qrel,hi);}while(0)
  f32x16 pA0,pA1,pB0,pB1;
  int sl_prev=0,sl_cur=0,sl_next=SLOTB;
  #define ROT() do{sl_prev=sl_cur;sl_cur=sl_next;sl_next=(sl_next==(NSLOT-1)*SLOTB)?0:sl_next+SLOTB;}while(0)
  DMA_K(2,2*SLOTB);
  bias_init(pA0,pA1,cum,bt,0,lane,hi,cwm);
  WAIT_BAR(3);
  qkt(pA0,pA1,Kbase,qr,r32,hi);CMASK(pA0,pA1,0);
  _Pragma("unroll") for(int r=0;r<16;++r){pA0[r]=__builtin_amdgcn_exp2f(pA0[r]);pA1[r]=__builtin_amdgcn_exp2f(pA1[r]);}
  WAIT_BAR(0);
  DMA_K(3,0);DMA_V(1,SLOTB);
  ROT();
  kload8(kf,kp0+sl_cur);
  WAIT_BAR(2);
  s16x4 vlo[8],vhi[8]; u32x4 pw0,pw1,pw2,pw3;
  #define PKW(P,B) cvtpk_s(P[B],P[B+1])
  #define PAF(k) __builtin_bit_cast(bf16x8,pw##k)
  #define VFR(i) (bf16x8){vlo[i][0],vlo[i][1],vlo[i][2],vlo[i][3],vhi[i][0],vhi[i][1],vhi[i][2],vhi[i][3]}
  #define PIN(x) asm volatile("":"+v"(x))
  #define GAPA(MF,A0,A1,A2,A3,W0,W1,PW) do{ MF; sacc+=A0; sacc+=A1; sacc+=A2; sacc+=A3; PIN(sacc); W0; W1; PIN(PW); SBAR(); }while(0)
  #define EX(v) __builtin_amdgcn_exp2f(v)
  #define GAPB(MF,X,B) do{ MF; X[B]=EX(X[B]); X[B+1]=EX(X[B+1]); X[B+2]=EX(X[B+2]); X[B+3]=EX(X[B+3]); PIN(X); SBAR(); }while(0)
  #define VRD(i) do{ vlo[i]=vtr(vp_+(((i)>>2)*4096+((i)&3)*1024)); vhi[i]=vtr(vp_+(((i)>>2)*4096+((i)&3)*1024+512)); }while(0)
  #define KRD(G,j) do{ if(G){ kload2(kf,kp0+sl_next,j); SBAR(); } }while(0)
  #define STEP(C0,C1,P0,P1,t,GK,GV,GL) do{ SBAR(); \
    bias_init(C0,C1,cum,bt,(t),lane,hi,cwm); SBAR(); \
    const lds_cptr vp_=vp0+sl_prev; \
    VRD(0); SBAR(); float sacc=(P0[0]+P0[1]); \
    GAPA(C0=__builtin_amdgcn_mfma_f32_32x32x16_bf16(kf[0],qr[0],C0,0,0,0), P0[2],P0[3],P0[4],P0[5],     pw0[0]=PKW(P0,0), pw0[1]=PKW(P0,2), pw0); \
    VRD(4); SBAR(); GAPA(C1=__builtin_amdgcn_mfma_f32_32x32x16_bf16(kf[1],qr[0],C1,0,0,0), P0[6],P0[7],P0[8],P0[9],     pw0[2]=PKW(P0,4), pw0[3]=PKW(P0,6), pw0); \
    VRD(1); SBAR(); GAPA(C0=__builtin_amdgcn_mfma_f32_32x32x16_bf16(kf[2],qr[1],C0,0,0,0),   P0[10],P0[11],P0[12],P0[13], pw1[0]=PKW(P0,8), pw1[1]=PKW(P0,10), pw1); \
    VRD(5); SBAR(); GAPA(C1=__builtin_amdgcn_mfma_f32_32x32x16_bf16(kf[3],qr[1],C1,0,0,0),   P0[14],P0[15],P1[0],P1[1],   pw1[2]=PKW(P0,12),pw1[3]=PKW(P0,14), pw1); \
    VRD(2); SBAR(); GAPA(C0=__builtin_amdgcn_mfma_f32_32x32x16_bf16(kf[4],qr[2],C0,0,0,0),   P1[2],P1[3],P1[4],P1[5],     pw2[0]=PKW(P1,0), pw2[1]=PKW(P1,2), pw2); \
    VRD(6); SBAR(); GAPA(C1=__builtin_amdgcn_mfma_f32_32x32x16_bf16(kf[5],qr[2],C1,0,0,0),   P1[6],P1[7],P1[8],P1[9],     pw2[2]=PKW(P1,4), pw2[3]=PKW(P1,6), pw2); \
    VRD(3); SBAR(); GAPA(C0=__builtin_amdgcn_mfma_f32_32x32x16_bf16(kf[6],qr[3],C0,0,0,0),   P1[10],P1[11],P1[12],P1[13], pw3[0]=PKW(P1,8), pw3[1]=PKW(P1,10), pw3); \
    VRD(7); SBAR(); GAPA(C1=__builtin_amdgcn_mfma_f32_32x32x16_bf16(kf[7],qr[3],C1,0,0,0),   P1[14],P1[15],0.f,0.f,       pw3[2]=PKW(P1,12),pw3[3]=PKW(P1,14), pw3); \
    l_reg+=sacc; \
    if(GK){DMA_K((t)+3,sl_cur);} if(GV){DMA_V((t)+1,sl_next);} \
    CMASK(C0,C1,t); \
    SBAR(); \
    GAPB(o[0]=__builtin_amdgcn_mfma_f32_32x32x16_bf16(PAF(0),VFR(0),o[0],0,0,0), C0,0); \
    GAPB(o[1]=__builtin_amdgcn_mfma_f32_32x32x16_bf16(PAF(0),VFR(4),o[1],0,0,0), C0,4); \
    KRD(GL,0); GAPB(o[0]=__builtin_amdgcn_mfma_f32_32x32x16_bf16(PAF(1),VFR(1),o[0],0,0,0), C0,8); \
    KRD(GL,1); GAPB(o[1]=__builtin_amdgcn_mfma_f32_32x32x16_bf16(PAF(1),VFR(5),o[1],0,0,0), C0,12); \
    KRD(GL,2); GAPB(o[0]=__builtin_amdgcn_mfma_f32_32x32x16_bf16(PAF(2),VFR(2),o[0],0,0,0), C1,0); \
    KRD(GL,3); GAPB(o[1]=__builtin_amdgcn_mfma_f32_32x32x16_bf16(PAF(2),VFR(6),o[1],0,0,0), C1,4); \
    GAPB(o[0]=__builtin_amdgcn_mfma_f32_32x32x16_bf16(PAF(3),VFR(3),o[0],0,0,0), C1,8); \
    GAPB(o[1]=__builtin_amdgcn_mfma_f32_32x32x16_bf16(PAF(3),VFR(7),o[1],0,0,0), C1,12); \
    }while(0)
  int t=1;
  #undef CMASK
  #define CMASK(P0,P1,t) do{}while(0)
  for(;t+5<NT;t+=2){
    STEP(pB0,pB1,pA0,pA1,t,true,true,true);     WAIT_BAR(2); ROT();
    STEP(pA0,pA1,pB0,pB1,t+1,true,true,true);   WAIT_BAR(2); ROT();
  }
  #undef CMASK
  #define CMASK(P0,P1,t) do{int jb_=(t)-(NT-4); if(jb_>=0)cmask(P0,P1,jb_,qrel,hi);}while(0)
  #define ENDW(tt) do{ if((tt)+3<NT){WAIT_BAR(2);} else if((tt)+2<NT){WAIT_BAR(1);} else {WAIT_BAR(0);} }while(0)
  for(;t+1<NT;t+=2){
    STEP(pB0,pB1,pA0,pA1,t,(t+3<NT),(t+1<NT),(t+1<NT));       ENDW(t);   ROT();
    STEP(pA0,pA1,pB0,pB1,t+1,(t+4<NT),(t+2<NT),(t+2<NT));     ENDW(t+1); ROT();
  }
  STEP(pB0,pB1,pA0,pA1,NT-1,false,false,false);
  { float sacc=pB0[0]+pB0[1]; _Pragma("unroll") for(int r=2;r<16;++r)sacc+=pB0[r]; _Pragma("unroll") for(int r=0;r<16;++r)sacc+=pB1[r]; l_reg+=sacc;
    pw0=(u32x4){PKW(pB0,0),PKW(pB0,2),PKW(pB0,4),PKW(pB0,6)};pw1=(u32x4){PKW(pB0,8),PKW(pB0,10),PKW(pB0,12),PKW(pB0,14)};pw2=(u32x4){PKW(pB1,0),PKW(pB1,2),PKW(pB1,4),PKW(pB1,6)};pw3=(u32x4){PKW(pB1,8),PKW(pB1,10),PKW(pB1,12),PKW(pB1,14)};
    SBAR(); pv(o,vb0+sl_cur,PAF(0),PAF(1),PAF(2),PAF(3)); }
  #undef PKW
  #undef PAF
  #undef VFR
  #undef PIN
  #undef GAPA
  #undef GAPB
  #undef EX
  #undef VRD
  #undef KRD
  #undef STEP
  #undef ENDW
  asm volatile("s_waitcnt lgkmcnt(0)\n\ts_barrier":::"memory");
  if(qb_next>=0){ const bf16*Qn=Q+(rowbase+qb_next*QB+wid*QBLK)*DM+h*D;
    DMA_K(0,0);DMA_V(0,0);DMA_K(1,SLOTB);
    #pragma unroll
    for(int d0=0;d0<4;++d0)qr[d0]=*reinterpret_cast<const bf16x8*>(&Qn[(long)r32*DM+d0*16+hi*8]); }
  float*wsf=(float*)(shm+LDS_WS)+wid*64;
  {auto rr=__builtin_amdgcn_permlane32_swap(__float_as_uint(l_reg),__float_as_uint(l_reg),false,false);l_reg=__uint_as_float(rr[0])+__uint_as_float(rr[1]);}
  if(hi==0)wsf[32+r32]=l_reg;asm volatile("s_waitcnt lgkmcnt(0)":::"memory");
  float rli[16];
  #pragma unroll
  for(int r=0;r<16;++r)rli[r]=__builtin_amdgcn_rcpf(wsf[32+crow(r,hi)]);
  bf16*Ow=O+(rowbase+q0+wid*QBLK)*DM+h*D; const bf16*Gw=SG+(rowbase+q0+wid*QBLK)*DM+h*D;
  { float*stg=(float*)(shm+LDS_OST)+wid*2048;
    #pragma unroll
    for(int r=0;r<16;++r){const int orow=crow(r,hi);
      #pragma unroll
      for(int d0=0;d0<2;++d0)stg[orow*64+d0*32+r32]=o[d0][r]*rli[r];}
    asm volatile("s_waitcnt lgkmcnt(0)":::"memory");
    #pragma unroll
    for(int i=0;i<4;++i){const int row=i*8+(lane>>3),ch=lane&7; const f32x4 v0=*(const f32x4*)(stg+row*64+ch*8), v1=*(const f32x4*)(stg+row*64+ch*8+4);
      const u32x4 g=__builtin_nontemporal_load((const u32x4*)(Gw+(long)row*DM+ch*8)); u32x4 w;
      w.x=cvtpk_s(v0[0]*__uint_as_float(g.x<<16),v0[1]*__uint_as_float(g.x&0xffff0000u)); w.y=cvtpk_s(v0[2]*__uint_as_float(g.y<<16),v0[3]*__uint_as_float(g.y&0xffff0000u));
      w.z=cvtpk_s(v1[0]*__uint_as_float(g.z<<16),v1[1]*__uint_as_float(g.z&0xffff0000u)); w.w=cvtpk_s(v1[2]*__uint_as_float(g.w<<16),v1[3]*__uint_as_float(g.w&0xffff0000u));
      *(u32x4*)(Ow+(long)row*DM+ch*8)=w;} }
  if(qb_next<0) asm volatile("s_waitcnt lgkmcnt(0)\n\ts_barrier":::"memory");
  #undef DMA_K
  #undef DMA_V
  #undef CMASK
  #undef ROT
}
#undef SBAR
#undef WAIT_BAR
}
struct Args { const float* in[29]; float* out; unsigned char* ws; unsigned phmask; int li; };
__global__ void __launch_bounds__(NWAVES * 64, 2) mk_fwd(Args args) {
    extern __shared__ __attribute__((aligned(16))) unsigned char lds_raw[];
    LAS unsigned char* lds = (LAS unsigned char*)lds_raw;
    volatile LAS unsigned* MISC = (volatile LAS unsigned*)(lds + MISC_OFF);
    const int tid0 = threadIdx.x;
    const int G0 = gridDim.x; const int bx0 = blockIdx.x; const int vcu0 = (G0 % 8 == 0) ? (bx0 % 8) * (G0 / 8) + bx0 / 8 : bx0;
    for (int u = tid0; u < (LDS_BYTES - LDSCTL_OFF) / 4; u += NWAVES * 64) ((LAS unsigned*)(lds + LDSCTL_OFF))[u] = 0u;
    __syncthreads();
    XcdBarrier bar = xcd_barrier_post((unsigned*)(args.ws + WS_CTL) + CW_BAR + args.li * XCD_BAR_WORDS, MISC + 8);
    const unsigned mask = args.phmask; bool first = true;
#define SEAM() do { if (!first) { if (ph == 1 || ph == 7) __syncthreads(); else if (ph != 2 && MISC[10] != 0u) xcd_local_barrier(bar); else xcd_barrier(bar); } first = false; } while (0)
#ifndef PH_EN
#define PH_EN 0xFFFFu
#endif
#define IN(p) (((PH_EN >> (p)) & 1u) && (mask & (1u << (p))))

#pragma unroll 1
    for (int it = 0; it < 15; ++it) {
        const int ph = (it == 1) ? 7 : (it >= 2 && it <= 7) ? it - 1 : it;
        if (!IN(ph)) continue;
        SEAM();
        const int reg = __builtin_amdgcn_readfirstlane((int)MISC[10]), xcc = __builtin_amdgcn_readfirstlane((int)bar.x), rank = __builtin_amdgcn_readfirstlane((int)MISC[11]);
        int tid = tid0, vcu = reg ? xcc * 32 + rank : vcu0, G = G0, bx = reg ? rank * 8 + xcc : bx0; unsigned long long zoff = 0ull; asm volatile("" : "+v"(tid), "+s"(vcu), "+s"(zoff), "+s"(G), "+s"(bx));
        unsigned char* ws = args.ws + zoff;
        const int lane = tid & 63, wave = __builtin_amdgcn_readfirstlane(tid >> 6), gw = vcu * NWAVES + wave, NGW = G * NWAVES;
        bf16* XB = (bf16*)(ws + WS_XB); float* SSQ = (float*)(ws + WS_SSQ);
#define ACT_PTR(flat_off, arena_off, row_bytes) (reg ? ws + WS_ACT + (size_t)xcc * ARENA_BYTES + (arena_off) - (size_t)xcc * 2048 * (row_bytes) : ws + (flat_off))
        unsigned char* pUG = ACT_PTR(WS_UG, 0, 4096); unsigned char* pGV = ACT_PTR(WS_GV, 8 * MiB, 4096);
        unsigned char* pXBR = ACT_PTR(WS_XBR, 0, 3072); unsigned char* pLSG = ACT_PTR(WS_LSG, 6 * MiB, 3072); unsigned char* pLY = ACT_PTR(WS_LY, 12 * MiB, 3072);
        unsigned char* pQ = ACT_PTR(WS_Q, 0, 2048); unsigned char* pK = ACT_PTR(WS_K, 4 * MiB, 2048); unsigned char* pV = ACT_PTR(WS_V, 8 * MiB, 2048); unsigned char* pFSG = ACT_PTR(WS_FSG, 12 * MiB, 2048);
#undef ACT_PTR
        switch (ph) {
        case 0: p0_weights<0>(args, ws, lds, gw, NGW, lane, wave); break;
        case 7: p0_weights<1>(args, ws, lds, gw, NGW, lane, wave); break;
        case 1: p_prep(args.in[0], XB, SSQ, gw, NGW, lane); break;
        case 2: case 12: {
            pg8::Gemm g{XB, (const bf16*)(ws + (ph == 2 ? WS_W0IN : WS_W3IN)), M_, 6144, 1024}; pg8::StaticOrder S; S.init(M_, 6144, G, bx);
            rstd_table(lds, S, SSQ, tid);
            pg8::EpiGmlp1 E{(const LAS float*)(lds + RSTD_TAB_OFF), (bf16*)pUG, (bf16*)pGV, (float*)(ws + WS_VSSQ), 0};
            pg8::gemm_phase<pg8::EpiGmlp1, pg8::StaticOrder, true, true>(lds, g, S, E); } break;
        case 3: case 13: {
            const float* g_vnorm = ph == 3 ? args.in[3] : args.in[25]; const float* g_ws = ph == 3 ? args.in[4] : args.in[26]; const float* g_bs = ph == 3 ? args.in[5] : args.in[27];
            mix_phase_w(lds, 4 * (vcu >> 3), vcu & 7, (vcu < 256) ? 4 : 0, (const bf16*)pGV, (bf16*)pUG, (const float*)(ws + WS_VSSQ), g_ws, g_bs, g_vnorm, tid, lane, wave);
            __syncthreads(); } break;
        case 4: case 8: case 11: case 14: {
            const bf16* A = (const bf16*)(ph == 8 ? pLY : (ph == 11 ? pQ : pUG));
            const bf16* Bt = (const bf16*)(ws + (ph == 4 ? WS_W0OUT : ph == 8 ? WS_W1OUT : ph == 11 ? WS_W2OUT : WS_W3OUT));
            const int K = ph == 8 ? 1536 : (ph == 11 ? 1024 : 2048);
            pg8::Gemm g{A, Bt, M_, 1024, K}; pg8::StaticOrder S; S.init(M_, 1024, G, bx);
            pg8::EpiRes E{args.in[0], args.out, XB, SSQ, ph == 14 ? 2 : 1};
            pg8::gemm_phase<pg8::EpiRes, pg8::StaticOrder, false, true>(lds, g, S, E); } break;
        case 5: {
            pg8::Gemm g{XB, (const bf16*)(ws + WS_W1IN), M_, 3072, 1024}; pg8::StaticOrder S; S.init(M_, 3072, G, bx);
            rstd_table(lds, S, SSQ, tid);
            pg8::EpiLru1 E{(const LAS float*)(lds + RSTD_TAB_OFF), (bf16*)pXBR, (bf16*)pLSG, 0};
            pg8::gemm_phase<pg8::EpiLru1, pg8::StaticOrder, true, true>(lds, g, S, E); } break;
        case 6: {
            for (int I = vcu; I < 256; I += G)
                lru_item(lds, I >> 5, (I >> 1) & 15, I & 1, (const bf16*)pXBR, (const bf16*)pLSG, (bf16*)pLY, (const bf16*)(ws + WS_WAT), (const bf16*)(ws + WS_WXT), args.in[9], args.in[10], args.in[12], args.in[14], args.in[15], tid, lane, wave);
            } break;
        case 9: {
            pg8::Gemm g{XB, (const bf16*)(ws + WS_W2IN), M_, 4096, 1024}; pg8::StaticOrder S; S.init(M_, 4096, G, bx);
            { LAS float* GT = (LAS float*)(lds + RSTD_TAB_OFF + 6144); if (tid < 64) GT[tid] = args.in[20][tid] * attn_body::C2; else if (tid < 128) GT[tid] = args.in[21][tid - 64]; }
            rstd_table(lds, S, SSQ, tid);
            pg8::EpiFox1 E{(const LAS float*)(lds + RSTD_TAB_OFF), (bf16*)pQ, (bf16*)pK, (bf16*)pV, (bf16*)pFSG, (const LAS float*)(lds + RSTD_TAB_OFF + 6144), 0};
            pg8::gemm_phase<pg8::EpiFox1, pg8::StaticOrder, true, true>(lds, g, S, E);
            flogit_phase(XB, (const bf16*)(ws + WS_WF), SSQ, args.in[19], (float*)(ws + WS_LOGF), vcu, G, wave, lane); } break;
        case 10: {
            bf16* FQ = (bf16*)pQ; const float* LOGF = (const float*)(ws + WS_LOGF);
            const int bh = vcu >> 1, sl = vcu & 1, ab = bh >> 4, ah = bh & 15;
            { LAS float* cum = (LAS float*)(lds + attn_body::LDS_CUM); LAS float* wt = (LAS float*)(lds + attn_body::LDS_WS);
              const f32x4 lf4 = *(const f32x4*)(LOGF + ((size_t)ab * 16 + ah) * SEQ_ + 4 * tid); float v0 = lf4[0], v1 = lf4[1], v2 = lf4[2], v3 = lf4[3];
              v1 += v0; v2 += v1; v3 += v2; float s = v3;
#pragma unroll
              for (int o = 1; o < 64; o <<= 1) { const float n = __shfl_up(s, o); if (lane >= o) s += n; }
              if (lane == 63) wt[wave] = s;
              __syncthreads();
              float off = s - v3; for (int w = 0; w < wave; ++w) off += wt[w];
              const float k = 1.4426950408889634f;
              *(LAS f32x4*)(cum + 4 * tid) = (f32x4){(v0 + off) * k, (v1 + off) * k, (v2 + off) * k, (v3 + off) * k};
              __syncthreads(); }
            float mq = fabsf(args.in[20][lane]), mk = fabsf(args.in[21][lane]);
#pragma unroll
            for (int o = 1; o < 64; o <<= 1) { mq = fmaxf(mq, __shfl_xor(mq, o)); mk = fmaxf(mk, __shfl_xor(mk, o)); }
            const float mref = attn_body::C2 * 64.0f * mq * mk;
            pg8::bf16x8 qreg[4];
#pragma unroll
            for (int d0 = 0; d0 < 4; ++d0) qreg[d0] = (pg8::bf16x8){0, 0, 0, 0, 0, 0, 0, 0};
#define ATT_QB(i_) (sl == 0 ? ((i_) == 0 ? 7 : (i_) == 1 ? 4 : (i_) == 2 ? 3 : 0) : ((i_) == 0 ? 6 : (i_) == 1 ? 5 : (i_) == 2 ? 2 : 1))
#pragma unroll 1
            for (int i = 0; i < 4; ++i)
                attn_body::attn_unit(ab, ah, ATT_QB(i), FQ, (const bf16*)pK, (const bf16*)pV, (const bf16*)pFSG, FQ, (char*)lds_raw, mref, qreg, i > 0, i < 3 ? ATT_QB(i + 1) : -1);
#undef ATT_QB
            } break;
        default: break;
        }
    }
#undef SEAM
#undef IN
}
extern "C" void kernel_launch(void* const* d_in, const int* in_sizes, int n_in, void* d_out, int out_size, void* d_ws, size_t ws_size, hipStream_t stream) {
    static int grid = 0;
    if (grid == 0) {
        if (n_in != 29 || in_sizes[0] != M_ * DM_ || out_size != M_ * DM_ || ws_size < WS_END) { fprintf(stderr, "kernel_launch: unexpected shapes (n_in %d, ws %zu)\n", n_in, ws_size); grid = -1; return; }
        int dev = 0, cus = 0;
        if (hipGetDevice(&dev) != hipSuccess || hipDeviceGetAttribute(&cus, hipDeviceAttributeMultiprocessorCount, dev) != hipSuccess) { grid = -1; return; }
        if (hipFuncSetAttribute((const void*)mk_fwd, hipFuncAttributeMaxDynamicSharedMemorySize, LDS_BYTES) != hipSuccess) { fprintf(stderr, "kernel_launch: hipFuncSetAttribute failed\n"); grid = -1; return; }
        int per_cu = 0;
        if (hipOccupancyMaxActiveBlocksPerMultiprocessor(&per_cu, (const void*)mk_fwd, NWAVES * 64, LDS_BYTES) != hipSuccess || per_cu < 1) fprintf(stderr, "kernel_launch: occupancy query says %d\n", per_cu);
        (void)hipGetLastError();
        grid = cus;
        if (grid != 256) fprintf(stderr, "kernel_launch: built for a 256-CU device (one out-projection tile / LRU item / attention head pair per CU); got %d CUs\n", grid);
    }
    if (grid < 0) return;
    (void)hipMemsetAsync((char*)d_ws + WS_CTL, 0, CTL_ZERO_BYTES, stream);
    Args a{};
    for (int i = 0; i < 29; ++i) a.in[i] = (const float*)d_in[i];
    a.out = (float*)d_out; a.ws = (unsigned char*)d_ws; a.phmask = 0x7FFFu; a.li = 0;
    hipLaunchKernelGGL(mk_fwd, dim3(grid), dim3(NWAVES * 64), LDS_BYTES, stream, a);
}
```

```cpp
#include <hip/hip_runtime.h>
#include <cstdio>
#include <cstdint>
#ifndef PG8_WGM
#define PG8_WGM 8
#endif
namespace pg8 {
#define PG8_LAS __attribute__((address_space(3)))
typedef unsigned short bf16_t;
typedef short bf16x8 __attribute__((ext_vector_type(8)));
typedef float f32x4 __attribute__((ext_vector_type(4)));
typedef unsigned u32x4 __attribute__((ext_vector_type(4)));
constexpr int BM = 256, BK = 64, HALF = 128, HTB = HALF * BK * 2  , STAGE_BYTES = 8 * HTB, NXCD = 8, WGM = PG8_WGM;

__host__ __device__ __forceinline__ int lds_byte(int r, int c) { const int st = (r >> 4) * 2 + (c >> 5), rr = r & 15, cc = c & 31, ob = rr * 64 + cc * 2; return st * 1024 + (ob ^ (((ob >> 9) & 1) << 5)); }
__host__ __device__ __forceinline__ void stage_rc(int b, int& R, int& C) { const int st = b / 1024, sb = b % 1024, swz = sb ^ (((sb >> 9) & 1) << 5); R = (st >> 1) * 16 + swz / 64; C = (st & 1) * 32 + (swz % 64) / 2; }
__host__ __device__ __forceinline__ int perm32(int rho) { const int n = rho >> 4, i = rho & 15; return 8 * (i >> 2) + 4 * n + (i & 3); }

struct Unit { int pm, pn; };
struct Gemm { const bf16_t* A; const bf16_t* Bt; int M, N, K; };

struct StaticOrder {
    int nM, nN, nwg, G, c;
    __host__ __device__ void init(int M, int N, int G_, int c_) { nM = M / BM; nN = N / BM; nwg = nM * nN; G = G_; c = c_; }
    __host__ __device__ bool next(int i, Unit& u) const {
        const long L = (long)i * G + c; if (L >= nwg) return false;
        int wgid = (int)L; { const int q = nwg / NXCD, r = nwg % NXCD, xcd = wgid % NXCD, off = wgid / NXCD; wgid = (xcd < r ? xcd * (q + 1) : r * (q + 1) + (xcd - r) * q) + off; }
        const int nig = WGM * nN, gid = wgid / nig, fm = gid * WGM, gsz = (nM - fm) < WGM ? (nM - fm) : WGM;
        u.pm = fm + ((wgid % nig) % gsz); u.pn = (wgid % nig) / gsz; return true;
    }
    __device__ __forceinline__ void a_ready(const Unit&) const {}
    __device__ __forceinline__ void done(const Unit&) const {}
};

__device__ __forceinline__ unsigned cvt_pk_bf16(float lo, float hi) { unsigned r; asm volatile("v_cvt_pk_bf16_f32 %0, %1, %2" : "=v"(r) : "v"(lo), "v"(hi)); return r; }
typedef float f32x2 __attribute__((ext_vector_type(2)));
__device__ __forceinline__ float gelu_t(float x) { const float u = x * (1.0f + 0.044715f * x * x); return x * __builtin_amdgcn_rcpf(1.0f + __builtin_amdgcn_exp2f(-2.3022082f * u)); }
__device__ __forceinline__ float silu_f(float x) { return x * __builtin_amdgcn_rcpf(1.0f + __builtin_amdgcn_exp2f(-1.4426950409f * x)); }
__device__ __forceinline__ float row_rstd(const float* ssq, int row) { const f32x4 s = *(const f32x4*)(ssq + (size_t)row * 4); return rsqrtf(((s[0] + s[1]) + (s[2] + s[3])) * (1.0f / 1024.0f) + 1e-6f); }
typedef float f32x2v_ __attribute__((ext_vector_type(2))); typedef __bf16 bf16x2v_ __attribute__((ext_vector_type(2)));
__device__ __forceinline__ unsigned cvt2(float lo, float hi) { f32x2v_ v = {lo, hi}; return __builtin_bit_cast(unsigned, __builtin_convertvector(v, bf16x2v_)); }
__device__ __forceinline__ u32x4 pack8_old(const f32x4 a, const f32x4 b) { u32x4 w; w.x = cvt_pk_bf16(a[0], a[1]); w.y = cvt_pk_bf16(a[2], a[3]); w.z = cvt_pk_bf16(b[0], b[1]); w.w = cvt_pk_bf16(b[2], b[3]); return w; }

__device__ __forceinline__ void load_rstd8(const PG8_LAS float* tab, int ord, int wr, int fr, float (&rs)[2][4]) {
#pragma unroll
    for (int ai = 0; ai < 2; ++ai)
#pragma unroll
        for (int m = 0; m < 4; ++m) rs[ai][m] = tab[ord * 256 + wr * 64 + fr + ai * HALF + m * 16];
}
__device__ __forceinline__ u32x4 pack8(const f32x4 a, const f32x4 b) { u32x4 w; w.x = cvt2(a[0], a[1]); w.y = cvt2(a[2], a[3]); w.z = cvt2(b[0], b[1]); w.w = cvt2(b[2], b[3]); return w; }
__device__ __forceinline__ float gelu_silu(float u, float g) { const float t = u * u; const float e1 = __builtin_amdgcn_exp2f(fminf(u * fmaf(t, -0.10294324f, -2.3022082f), 60.0f)); const float e2 = __builtin_amdgcn_exp2f(fminf(-1.4426950409f * g, 60.0f));
    const float a1 = 1.0f + e1; return (u * g) * __builtin_amdgcn_rcpf(fmaf(a1, e2, a1)); }
__device__ __forceinline__ float gelu_t2(float x) { const float t = x * x; return x * __builtin_amdgcn_rcpf(1.0f + __builtin_amdgcn_exp2f(x * fmaf(t, -0.10294324f, -2.3022082f))); }

__device__ __forceinline__ f32x2 pk_fma2(f32x2 a, f32x2 b, f32x2 c) { return __builtin_elementwise_fma(a, b, c); }
__device__ __forceinline__ f32x2 lo2(const f32x4 v) { return (f32x2){v[0], v[1]}; }
__device__ __forceinline__ f32x2 hi2(const f32x4 v) { return (f32x2){v[2], v[3]}; }
__device__ __forceinline__ f32x2 gelu_p(f32x2 x) { const f32x2 t = x * x; const f32x2 a = x * pk_fma2(t, (f32x2){-0.10294324f, -0.10294324f}, (f32x2){-2.3022082f, -2.3022082f});
    const f32x2 d = (f32x2){__builtin_amdgcn_exp2f(a[0]), __builtin_amdgcn_exp2f(a[1])} + (f32x2){1.0f, 1.0f}; return x * (f32x2){__builtin_amdgcn_rcpf(d[0]), __builtin_amdgcn_rcpf(d[1])}; }
__device__ __forceinline__ f32x2 silu_p(f32x2 x) { const f32x2 a = x * (f32x2){-1.4426950409f, -1.4426950409f};
    const f32x2 d = (f32x2){__builtin_amdgcn_exp2f(a[0]), __builtin_amdgcn_exp2f(a[1])} + (f32x2){1.0f, 1.0f}; return x * (f32x2){__builtin_amdgcn_rcpf(d[0]), __builtin_amdgcn_rcpf(d[1])}; }
__device__ __forceinline__ f32x2 gelu_silu_p(f32x2 u, f32x2 g) { const f32x2 t = u * u; const f32x2 a = u * pk_fma2(t, (f32x2){-0.10294324f, -0.10294324f}, (f32x2){-2.3022082f, -2.3022082f}); const f32x2 b = g * (f32x2){-1.4426950409f, -1.4426950409f};
    const f32x2 a1 = (f32x2){__builtin_amdgcn_exp2f(fminf(a[0], 60.0f)), __builtin_amdgcn_exp2f(fminf(a[1], 60.0f))} + (f32x2){1.0f, 1.0f}; const f32x2 e2 = (f32x2){__builtin_amdgcn_exp2f(b[0]), __builtin_amdgcn_exp2f(b[1])};
    const f32x2 d = pk_fma2(a1, e2, a1); return (u * g) * (f32x2){__builtin_amdgcn_rcpf(d[0]), __builtin_amdgcn_rcpf(d[1])}; }
__device__ __forceinline__ u32x4 pack8p(const f32x2 a, const f32x2 b, const f32x2 c, const f32x2 d) { u32x4 w; w.x = cvt2(a[0], a[1]); w.y = cvt2(b[0], b[1]); w.z = cvt2(c[0], c[1]); w.w = cvt2(d[0], d[1]); return w; }

struct EpiGmlp1 {
    static constexpr bool PERM = true, AFTER_DRAIN = false;
    const PG8_LAS float* rtab; bf16_t* UG; bf16_t* GV; float* vssq; mutable int ord;
    const float* ssq;
    template <class Sched> __device__ __forceinline__ void pre(const Sched& S, int tid) const { Unit u; for (int i = 0; S.next(i, u); ++i) if (tid < 256) ((PG8_LAS float*)rtab)[i * 256 + tid] = row_rstd(ssq, u.pm * 256 + tid); }
    __device__ __forceinline__ void operator()(const f32x4 (&acc)[2][2][4][2], const Unit& u, int wr, int wc, int fr, int fq) const {
        const int row0 = u.pm * BM + wr * 64 + fr; float rs8[2][4]; load_rstd8(rtab, ord++, wr, fr, rs8);
        if (u.pn < 16) {
            const int col = u.pn * 128 + wc * 32 + 8 * fq;
#pragma unroll
            for (int ai = 0; ai < 2; ++ai)
#pragma unroll
                for (int m = 0; m < 4; ++m) { const int r = row0 + ai * HALF + m * 16; const float rs = rs8[ai][m];
                    const f32x2 rs2 = {rs, rs};
                    const f32x2 o0 = gelu_silu_p(lo2(acc[ai][0][m][0]) * rs2, lo2(acc[ai][1][m][0]) * rs2), o1 = gelu_silu_p(hi2(acc[ai][0][m][0]) * rs2, hi2(acc[ai][1][m][0]) * rs2);
                    const f32x2 o2 = gelu_silu_p(lo2(acc[ai][0][m][1]) * rs2, lo2(acc[ai][1][m][1]) * rs2), o3 = gelu_silu_p(hi2(acc[ai][0][m][1]) * rs2, hi2(acc[ai][1][m][1]) * rs2);
                    *(u32x4*)(UG + (size_t)r * 2048 + col) = pack8p(o0, o1, o2, o3); asm volatile("" ::: "memory"); }
        } else {
            const int pv = u.pn - 16, col = pv * 256 + wc * 32 + 8 * fq;
#pragma unroll
            for (int ai = 0; ai < 2; ++ai)
#pragma unroll
                for (int m = 0; m < 4; ++m) { const int r = row0 + ai * HALF + m * 16; const float rs = rs8[ai][m]; const f32x2 rs2 = {rs, rs}; f32x2 ss2 = {0.f, 0.f};
#pragma unroll
                    for (int bj = 0; bj < 2; ++bj) {
                        const f32x2 o0 = gelu_p(lo2(acc[ai][bj][m][0]) * rs2), o1 = gelu_p(hi2(acc[ai][bj][m][0]) * rs2), o2 = gelu_p(lo2(acc[ai][bj][m][1]) * rs2), o3 = gelu_p(hi2(acc[ai][bj][m][1]) * rs2);
                        ss2 = pk_fma2(o0, o0, ss2); ss2 = pk_fma2(o1, o1, ss2); ss2 = pk_fma2(o2, o2, ss2); ss2 = pk_fma2(o3, o3, ss2);
                        *(u32x4*)(GV + (size_t)r * 2048 + col + bj * HALF) = pack8p(o0, o1, o2, o3); }
                    float ss = ss2[0] + ss2[1];
                    ss += __shfl_xor(ss, 16); ss += __shfl_xor(ss, 32);
                    if (fq == 0) vssq[(size_t)r * 32 + pv * 4 + wc] = ss; asm volatile("" ::: "memory"); }
        }
    }
};
struct EpiLru1 {
    static constexpr bool PERM = true, AFTER_DRAIN = false;
    const PG8_LAS float* rtab; bf16_t* XBR; bf16_t* SG; mutable int ord;
    const float* ssq;
    template <class Sched> __device__ __forceinline__ void pre(const Sched& S, int tid) const { Unit u; for (int i = 0; S.next(i, u); ++i) if (tid < 256) ((PG8_LAS float*)rtab)[i * 256 + tid] = row_rstd(ssq, u.pm * 256 + tid); }
    __device__ __forceinline__ void operator()(const f32x4 (&acc)[2][2][4][2], const Unit& u, int wr, int wc, int fr, int fq) const {
        const int row0 = u.pm * BM + wr * 64 + fr; const bool gate = u.pn >= 6; float rs8[2][4]; load_rstd8(rtab, ord++, wr, fr, rs8);
        bf16_t* base = gate ? SG : XBR; const int col = (gate ? u.pn - 6 : u.pn) * 256 + wc * 32 + 8 * fq;
#pragma unroll
        for (int ai = 0; ai < 2; ++ai)
#pragma unroll
            for (int m = 0; m < 4; ++m) { const int r = row0 + ai * HALF + m * 16; const float rs = rs8[ai][m];
#pragma unroll
                for (int bj = 0; bj < 2; ++bj) { const f32x2 rs2 = {rs, rs}; f32x2 o0 = lo2(acc[ai][bj][m][0]) * rs2, o1 = hi2(acc[ai][bj][m][0]) * rs2, o2 = lo2(acc[ai][bj][m][1]) * rs2, o3 = hi2(acc[ai][bj][m][1]) * rs2;
                    if (gate) { o0 = silu_p(o0); o1 = silu_p(o1); o2 = silu_p(o2); o3 = silu_p(o3); }
                    *(u32x4*)(base + (size_t)r * 1536 + col + bj * HALF) = pack8p(o0, o1, o2, o3); } asm volatile("" ::: "memory"); }
    }
};
struct EpiFox1 {
    static constexpr bool PERM = true, AFTER_DRAIN = false;
    const PG8_LAS float* rtab; bf16_t* Q; bf16_t* Kt; bf16_t* V; bf16_t* SG; const PG8_LAS float* gtab; mutable int ord;
    const float* ssq;
    template <class Sched> __device__ __forceinline__ void pre(const Sched& S, int tid) const { Unit u; for (int i = 0; S.next(i, u); ++i) if (tid < 256) ((PG8_LAS float*)rtab)[i * 256 + tid] = row_rstd(ssq, u.pm * 256 + tid); }
    __device__ __forceinline__ void operator()(const f32x4 (&acc)[2][2][4][2], const Unit& u, int wr, int wc, int fr, int fq) const {
        const int row0 = u.pm * BM + wr * 64 + fr; float rs8[2][4]; load_rstd8(rtab, ord++, wr, fr, rs8);
        if (u.pn < 8) {
            const bool isq = u.pn < 4; const PG8_LAS float* gn = gtab + (isq ? 0 : 64); bf16_t* base = isq ? Q : Kt;
            const int head = 4 * (u.pn & 3) + wc;
            f32x4 g[2][2];
#pragma unroll
            for (int bj = 0; bj < 2; ++bj)
#pragma unroll
                for (int n = 0; n < 2; ++n) g[bj][n] = *(const PG8_LAS f32x4*)(gn + 32 * bj + 8 * fq + 4 * n);
#pragma unroll
            for (int ai = 0; ai < 2; ++ai)
#pragma unroll
                for (int m = 0; m < 4; ++m) { const int r = row0 + ai * HALF + m * 16; const float rs = rs8[ai][m]; float ss = 0.f; f32x4 t[2][2];
#pragma unroll
                    for (int bj = 0; bj < 2; ++bj)
#pragma unroll
                        for (int n = 0; n < 2; ++n) { t[bj][n] = acc[ai][bj][m][n] * rs; ss += (t[bj][n][0] * t[bj][n][0] + t[bj][n][1] * t[bj][n][1]) + (t[bj][n][2] * t[bj][n][2] + t[bj][n][3] * t[bj][n][3]); }
                    ss += __shfl_xor(ss, 16); ss += __shfl_xor(ss, 32);
                    const float rh = rsqrtf(ss * (1.0f / 64.0f) + 1e-6f);
#pragma unroll
                    for (int bj = 0; bj < 2; ++bj) *(u32x4*)(base + (size_t)r * 1024 + 64 * head + 32 * bj + 8 * fq) = pack8(t[bj][0] * rh * g[bj][0], t[bj][1] * rh * g[bj][1]); asm volatile("" ::: "memory"); }
        } else {
            const bool gate = u.pn >= 12; bf16_t* base = gate ? SG : V; const int col = ((u.pn - 8) & 3) * 256 + wc * 32 + 8 * fq;
#pragma unroll
            for (int ai = 0; ai < 2; ++ai)
#pragma unroll
                for (int m = 0; m < 4; ++m) { const int r = row0 + ai * HALF + m * 16; const float rs = rs8[ai][m];
#pragma unroll
                    for (int bj = 0; bj < 2; ++bj) { const f32x2 rs2 = {rs, rs}; f32x2 o0 = lo2(acc[ai][bj][m][0]) * rs2, o1 = hi2(acc[ai][bj][m][0]) * rs2, o2 = lo2(acc[ai][bj][m][1]) * rs2, o3 = hi2(acc[ai][bj][m][1]) * rs2;
                        if (gate) { o0 = silu_p(o0); o1 = silu_p(o1); o2 = silu_p(o2); o3 = silu_p(o3); }
                        *(u32x4*)(base + (size_t)r * 1024 + col + bj * HALF) = pack8p(o0, o1, o2, o3); } asm volatile("" ::: "memory"); }
        }
    }
};
struct EpiRes {
    static constexpr bool PERM = true, AFTER_DRAIN = true;
    const float* xin; float* xout; bf16_t* XB; float* ssq; int mode;
    template <class Sched> __device__ __forceinline__ void pre(const Sched&, int) const {}
    __device__ __forceinline__ void fused(f32x4 (&acc)[2][2][4][2], const Unit& u, int wr, int wc, int fr, int fq, PG8_LAS unsigned char* lds, int wid, int lane) const {
        const int row0 = u.pm * BM + wr * 64 + fr, col0 = u.pn * BM + wc * 32 + 8 * fq;
        PG8_LAS float* P = (PG8_LAS float*)lds;
        const bool wxb = mode != 2;
        u32x4 cur[2], nx1[2];
#define EPIRES_ROW(it_) (row0 + ((it_) >> 2) * HALF + ((it_) & 3) * 16)
#define EPIRES_LOAD(dst, it_) do { _Pragma("unroll") for (int bj = 0; bj < 2; ++bj) dst[bj] = *(const u32x4*)(XB + (size_t)EPIRES_ROW(it_) * 1024 + col0 + bj * HALF); } while (0)
        EPIRES_LOAD(cur, 0);
#pragma unroll
        for (int it = 0; it < 8; ++it) { const int ai = it >> 2, m = it & 3; const int r = EPIRES_ROW(it); float ss = 0.f;
            if (it < 7) EPIRES_LOAD(nx1, it + 1);
            asm volatile("" ::: "memory");
#pragma unroll
            for (int bj = 0; bj < 2; ++bj) { const size_t off = (size_t)r * 1024 + col0 + bj * HALF; const u32x4 w_ = cur[bj];
                const f32x4 c0 = (f32x4){__uint_as_float(w_.x << 16), __uint_as_float(w_.x & 0xffff0000u), __uint_as_float(w_.y << 16), __uint_as_float(w_.y & 0xffff0000u)};
                const f32x4 c1 = (f32x4){__uint_as_float(w_.z << 16), __uint_as_float(w_.z & 0xffff0000u), __uint_as_float(w_.w << 16), __uint_as_float(w_.w & 0xffff0000u)};
                const f32x4 o0 = c0 + acc[ai][bj][m][0], o1 = c1 + acc[ai][bj][m][1];
                if (!wxb) { __builtin_nontemporal_store(o0, (f32x4*)(xout + off)); __builtin_nontemporal_store(o1, (f32x4*)(xout + off + 4)); }
                else { *(u32x4*)(XB + off) = pack8(o0, o1);
                    ss += ((o0[0] * o0[0] + o0[1] * o0[1]) + (o0[2] * o0[2] + o0[3] * o0[3])) + ((o1[0] * o1[0] + o1[1] * o1[1]) + (o1[2] * o1[2] + o1[3] * o1[3])); } }
            if (wxb) { ss += __shfl_xor(ss, 16); ss += __shfl_xor(ss, 32); if (fq == 0) P[(ai * HALF + wr * 64 + m * 16 + fr) * 4 + wc] = ss; }
            asm volatile("" ::: "memory");
#pragma unroll
            for (int bj = 0; bj < 2; ++bj) cur[bj] = nx1[bj]; }
#undef EPIRES_LOAD
#undef EPIRES_ROW
        if (wxb) {
            asm volatile("s_waitcnt lgkmcnt(0)" ::: "memory"); __builtin_amdgcn_s_barrier(); asm volatile("" ::: "memory");
            const int t = wid * 64 + lane;
            if (t < 256) { const f32x4 p = *(const PG8_LAS f32x4*)(P + t * 4); ssq[(size_t)(u.pm * BM + t) * 4 + u.pn] = (p[0] + p[1]) + (p[2] + p[3]); }
        }
    }
};
template <class Epi, class Sched, bool ALIGN_EPI = false, bool SP2 = false>
__device__ __forceinline__ void gemm_phase(PG8_LAS unsigned char* lds, const Gemm g, const Sched& S, const Epi& E) {
    int tid_ = threadIdx.x; asm volatile("" : "+v"(tid_));
    const int tid = tid_, wid = __builtin_amdgcn_readfirstlane(tid >> 6), lane = tid & 63, wr = wid >> 2, wc = wid & 3, fr = lane & 15, fq = lane >> 4;
    const int K = g.K, nt = K / BK;
    unsigned voffA[2], voffB[2];
#pragma unroll
    for (int i = 0; i < 2; ++i) { int R, C; stage_rc(tid * 16 + i * 8192, R, C); const int Rb = Epi::PERM ? ((R & ~31) + perm32(R & 31)) : R;
        voffA[i] = (unsigned)(R * K + C) * 2u; voffB[i] = (unsigned)(Rb * K + C) * 2u; }
    const size_t kstep = (size_t)(BK * 2);
    const size_t hstep = (size_t)HALF * K * 2;
    const size_t tstep = 2 * hstep;
    const unsigned ldsw = (unsigned)wid * 1024u;
    const int aoff = lds_byte(wr * 64 + fr, fq * 8), boff = lds_byte(wc * 32 + fr, fq * 8);
#define PG8_SA(b, h) (((b) * 2 + (h)) * HTB)
#define PG8_SB(b, h) ((4 + (b) * 2 + (h)) * HTB)
#define PG8_STAGE(bufoff, gbase, voff) do { _Pragma("unroll") for (int _i = 0; _i < 2; ++_i) \
        __builtin_amdgcn_global_load_lds((const unsigned*)((const char*)(gbase) + (voff)[_i]), (PG8_LAS unsigned*)(lds + (bufoff) + ldsw + _i * 8192), 16, 0, 0); } while (0)
#define PG8_LDA(dst, b, h) do { _Pragma("unroll") for (int m = 0; m < 4; ++m) _Pragma("unroll") for (int k = 0; k < 2; ++k) dst[m][k] = *(const PG8_LAS bf16x8*)(lds + PG8_SA(b, h) + aoff + m * 2048 + k * 1024); } while (0)
#define PG8_LDB(dst, b, h) do { _Pragma("unroll") for (int n = 0; n < 2; ++n) _Pragma("unroll") for (int k = 0; k < 2; ++k) dst[n][k] = *(const PG8_LAS bf16x8*)(lds + PG8_SB(b, h) + boff + n * 2048 + k * 1024); } while (0)
#define PG8_MMA(ai, bj, At, Bt) do { __builtin_amdgcn_s_setprio(1); _Pragma("unroll") for (int m = 0; m < 4; ++m) _Pragma("unroll") for (int n = 0; n < 2; ++n) _Pragma("unroll") for (int k = 0; k < 2; ++k) \
        acc[ai][bj][m][n] = __builtin_amdgcn_mfma_f32_16x16x32_bf16(Bt[n][k], At[m][k], acc[ai][bj][m][n], 0, 0, 0); __builtin_amdgcn_s_setprio(0); } while (0)
#define PG8_WAIT_V(n) asm volatile("s_waitcnt vmcnt(" #n ")" ::: "memory")
#define PG8_WAIT_L(n) asm volatile("s_waitcnt lgkmcnt(" #n ")" ::: "memory")
#define PG8_BAR __builtin_amdgcn_s_barrier()
#define PG8_SCHED __builtin_amdgcn_sched_barrier(0)
    Unit cur, nxt; int ui = 0;
    if (!S.next(0, cur)) return;
    f32x4 acc[2][2][4][2];
#pragma unroll
    for (int a = 0; a < 2; ++a)
#pragma unroll
        for (int b = 0; b < 2; ++b)
#pragma unroll
            for (int m = 0; m < 4; ++m)
#pragma unroll
                for (int n = 0; n < 2; ++n) acc[a][b][m][n] = (f32x4){0.f, 0.f, 0.f, 0.f};
    bf16x8 At[4][2], B0[2][2], B1[2][2];
    const char* cA = (const char*)g.A + (size_t)cur.pm * tstep; const char* cB = (const char*)g.Bt + (size_t)cur.pn * tstep;
    S.a_ready(cur);
    if constexpr (SP2) {
        PG8_STAGE(PG8_SB(0, 0), cB, voffB); PG8_STAGE(PG8_SB(0, 1), cB + hstep, voffB); PG8_STAGE(PG8_SA(0, 0), cA, voffA); PG8_STAGE(PG8_SA(0, 1), cA + hstep, voffA);
        E.pre(S, tid);
        if (wr == 1) PG8_BAR;
        PG8_WAIT_V(2); PG8_BAR;
        PG8_STAGE(PG8_SB(1, 0), cB + kstep, voffB); PG8_STAGE(PG8_SA(1, 0), cA + kstep, voffA); PG8_STAGE(PG8_SB(1, 1), cB + hstep + kstep, voffB);
        PG8_WAIT_V(6); PG8_BAR;
    } else {
        PG8_STAGE(PG8_SB(0, 0), cB, voffB); PG8_STAGE(PG8_SA(0, 0), cA, voffA); PG8_STAGE(PG8_SB(0, 1), cB + hstep, voffB); PG8_STAGE(PG8_SA(0, 1), cA + hstep, voffA);
        if (wr == 1) PG8_BAR;
        PG8_WAIT_V(4); PG8_BAR;
        PG8_STAGE(PG8_SB(1, 0), cB + kstep, voffB); PG8_STAGE(PG8_SA(1, 0), cA + kstep, voffA); PG8_STAGE(PG8_SB(1, 1), cB + hstep + kstep, voffB);
        PG8_WAIT_V(6); PG8_BAR;
    }
    for (;;) {
        const bool has_next = S.next(ui + 1, nxt);
        const char* nA = has_next ? (const char*)g.A + (size_t)nxt.pm * tstep : cA; const char* nB = has_next ? (const char*)g.Bt + (size_t)nxt.pn * tstep : cB;
        for (int t = 0; t < nt; t += 2) {
            const bool last = (t == nt - 2);
            const char* a1 = cA + (size_t)(t + 1) * kstep;
            const char* a2 = last ? nA : cA + (size_t)(t + 2) * kstep; const char* b2 = last ? nB : cB + (size_t)(t + 2) * kstep;
            const char* a3 = a2 + kstep; const char* b3 = b2 + kstep;
            if (last && has_next) S.a_ready(nxt);
            if constexpr (SP2) {
            PG8_LDB(B0, 0, 0); PG8_LDB(B1, 0, 1); PG8_SCHED; PG8_LDA(At, 0, 0); PG8_STAGE(PG8_SA(1, 1), a1 + hstep, voffA);
            PG8_WAIT_V(8); PG8_WAIT_L(0); PG8_BAR; PG8_MMA(0, 0, At, B0); PG8_MMA(0, 1, At, B1); PG8_BAR; PG8_SCHED;
            PG8_LDA(At, 0, 1); PG8_STAGE(PG8_SB(0, 0), b2, voffB); PG8_STAGE(PG8_SB(0, 1), b2 + hstep, voffB); PG8_STAGE(PG8_SA(0, 0), a2, voffA);
            PG8_WAIT_V(8); PG8_WAIT_L(0); PG8_BAR; PG8_MMA(1, 0, At, B0); PG8_MMA(1, 1, At, B1); PG8_BAR; PG8_SCHED;
            PG8_LDB(B0, 1, 0); PG8_LDB(B1, 1, 1); PG8_SCHED; PG8_LDA(At, 1, 0); PG8_STAGE(PG8_SA(0, 1), a2 + hstep, voffA);
            PG8_WAIT_V(8); PG8_WAIT_L(0); PG8_BAR; PG8_MMA(0, 0, At, B0); PG8_MMA(0, 1, At, B1); PG8_BAR; PG8_SCHED;
            PG8_LDA(At, 1, 1); PG8_STAGE(PG8_SB(1, 0), b3, voffB); PG8_STAGE(PG8_SB(1, 1), b3 + hstep, voffB); PG8_STAGE(PG8_SA(1, 0), a3, voffA);
            PG8_WAIT_V(8); PG8_WAIT_L(0); PG8_BAR; PG8_MMA(1, 0, At, B0); PG8_MMA(1, 1, At, B1); PG8_BAR; PG8_SCHED;
            } else {
            PG8_LDB(B0, 0, 0); PG8_SCHED; PG8_LDA(At, 0, 0); PG8_STAGE(PG8_SA(1, 1), a1 + hstep, voffA);
            PG8_WAIT_L(8); PG8_BAR; PG8_WAIT_L(0); PG8_MMA(0, 0, At, B0); PG8_BAR; PG8_SCHED;
            PG8_LDB(B1, 0, 1); PG8_STAGE(PG8_SB(0, 0), b2, voffB);
            PG8_BAR; PG8_WAIT_L(0); PG8_MMA(0, 1, At, B1); PG8_BAR;
            PG8_LDA(At, 0, 1); PG8_STAGE(PG8_SA(0, 0), a2, voffA);
            PG8_BAR; PG8_WAIT_L(0); PG8_MMA(1, 0, At, B0); PG8_BAR; PG8_SCHED;
            PG8_STAGE(PG8_SB(0, 1), b2 + hstep, voffB);
            PG8_WAIT_V(6); PG8_BAR; PG8_MMA(1, 1, At, B1); PG8_BAR;
            PG8_LDB(B0, 1, 0); PG8_SCHED; PG8_LDA(At, 1, 0); PG8_STAGE(PG8_SA(0, 1), a2 + hstep, voffA);
            PG8_WAIT_L(8); PG8_BAR; PG8_WAIT_L(0); PG8_MMA(0, 0, At, B0); PG8_BAR; PG8_SCHED;
            PG8_LDB(B1, 1, 1); PG8_STAGE(PG8_SB(1, 0), b3, voffB);
            PG8_BAR; PG8_WAIT_L(0); PG8_MMA(0, 1, At, B1); PG8_BAR;
            PG8_LDA(At, 1, 1); PG8_STAGE(PG8_SA(1, 0), a3, voffA);
            PG8_BAR; PG8_WAIT_L(0); PG8_MMA(1, 0, At, B0); PG8_BAR; PG8_SCHED;
            PG8_STAGE(PG8_SB(1, 1), b3 + hstep, voffB);
            PG8_WAIT_V(6); PG8_BAR; PG8_MMA(1, 1, At, B1); PG8_BAR;
            }
        }
        if constexpr (ALIGN_EPI) { if (wr == 0) PG8_BAR; }
        if constexpr (!Epi::AFTER_DRAIN) { E(acc, cur, wr, wc, fr, fq); S.done(cur); }
        if (!has_next) break;
#pragma unroll
        for (int a = 0; a < 2; ++a)
#pragma unroll
            for (int b = 0; b < 2; ++b)
#pragma unroll
                for (int m = 0; m < 4; ++m)
#pragma unroll
                    for (int n = 0; n < 2; ++n) acc[a][b][m][n] = (f32x4){0.f, 0.f, 0.f, 0.f};
        cur = nxt; cA = nA; cB = nB; ++ui;
        if constexpr (ALIGN_EPI) { if (wr == 1) PG8_BAR; }
    }
    PG8_WAIT_V(0);
    if constexpr (!ALIGN_EPI) { if (wr == 0) PG8_BAR; }
    PG8_BAR;
    if constexpr (Epi::AFTER_DRAIN) { E.fused(acc, cur, wr, wc, fr, fq, lds, wid, lane); S.done(cur); }
#undef PG8_SA
#undef PG8_SB
#undef PG8_STAGE
#undef PG8_LDA
#undef PG8_LDB
#undef PG8_MMA
#undef PG8_WAIT_V
#undef PG8_WAIT_L
#undef PG8_BAR
#undef PG8_SCHED
}
}
#define GAS __attribute__((address_space(1)))
#define LAS __attribute__((address_space(3)))
typedef unsigned short bf16;
typedef unsigned v4u __attribute__((ext_vector_type(4)));
typedef float f32x4 __attribute__((ext_vector_type(4)));
typedef short bf16x8 __attribute__((ext_vector_type(8)));
typedef GAS unsigned gu32;
typedef GAS unsigned long long gu64;
#define RLX_AGENT __ATOMIC_RELAXED, __HIP_MEMORY_SCOPE_AGENT
#define LDS_WAIT() asm volatile("s_waitcnt lgkmcnt(0)" ::: "memory")
#define VM_WAIT() asm volatile("s_waitcnt vmcnt(0)" ::: "memory")
__device__ __forceinline__ unsigned long long rt() { return __builtin_amdgcn_s_memrealtime(); }
__device__ __forceinline__ unsigned f2bf(float f) { unsigned u = __builtin_bit_cast(unsigned, f); return (u + 0x7fffu + ((u >> 16) & 1u)) >> 16; }
__device__ __forceinline__ unsigned pk2(float lo, float hi) { return f2bf(lo) | (f2bf(hi) << 16); }

#define XB_TMO      128
#define XB_XCNT(j)  (256  + 64 * (j))
#define XB_XSUB(j)  (1280 + 64 * (j))
#define XB_XGEN(j)  (2304 + 64 * (j))
#define XB_TOP      3328
#define XB_TOPGEN   3392
#define XCD_BAR_WORDS 3456
#define XB_SPIN_CAP (1u << 18)

__device__ __forceinline__ unsigned xb_ld(unsigned* p)              { return __hip_atomic_load(p, __ATOMIC_RELAXED, __HIP_MEMORY_SCOPE_AGENT); }
__device__ __forceinline__ unsigned xb_add(unsigned* p, unsigned v) { return __hip_atomic_fetch_add(p, v, __ATOMIC_RELAXED, __HIP_MEMORY_SCOPE_AGENT); }
__device__ __forceinline__ unsigned xb_xcc_id() { return (unsigned)__builtin_amdgcn_s_getreg((3 << 11) | 20) & 0xFu; }
#define XB_SPIN(cond, bar) do { unsigned _sp = 0; while (cond) { __builtin_amdgcn_s_sleep(1); \
    if ((++_sp & 255u) == 0u) { if (xb_ld(&(bar)[XB_TMO])) break; if (_sp > XB_SPIN_CAP) { atomicAdd(&(bar)[XB_TMO], 1u); break; } } } } while (0)

struct XcdBarrier {
    unsigned* bar; unsigned x;
    volatile LAS unsigned* st;
};

__device__ __forceinline__ XcdBarrier xcd_barrier_post(unsigned* bar, volatile LAS unsigned* st) {
    XcdBarrier b; b.bar = bar; b.x = xb_xcc_id(); b.st = st;
    if (threadIdx.x == 0) st[3] = xb_add(&bar[XB_XCNT(b.x)], 1u);
    return b;
}
__device__ __forceinline__ void xcd_barrier_complete(unsigned* bar, unsigned x, unsigned& nloc, unsigned& nx, unsigned& reg) {
    const unsigned G = gridDim.x * gridDim.y * gridDim.z;
    unsigned sum, cnt, mine, bad, sp = 0u;
    for (;;) {
        sum = 0u; cnt = 0u; mine = 0u; bad = 0u;
#pragma unroll
        for (unsigned j = 0; j < 16; ++j) { const unsigned c = xb_ld(&bar[XB_XCNT(j)]); sum += c; cnt += (c > 0u) ? 1u : 0u; mine = (j == x) ? c : mine; bad += (c != (j < 8u ? 32u : 0u)) ? 1u : 0u; }
        if (sum == G) break;
        __builtin_amdgcn_s_sleep(1);
        if ((++sp & 255u) == 0u) { if (xb_ld(&bar[XB_TMO])) break; if (sp > XB_SPIN_CAP) { atomicAdd(&bar[XB_TMO], 1u); break; } }
    }
    nloc = mine > 0u ? mine : 1u; nx = cnt > 0u ? cnt : 1u; reg = (sum == G && G == 256u && bad == 0u) ? 1u : 0u;
}

__device__ __forceinline__ void xcd_barrier(const XcdBarrier& b) {
    asm volatile("s_waitcnt vmcnt(0)" ::: "memory");
    __syncthreads();
    if (threadIdx.x == 0) {
        unsigned* bar = b.bar; unsigned bx_ = b.x; asm volatile("" : "+s"(bar), "+s"(bx_));
        __builtin_amdgcn_s_waitcnt(0);
        unsigned nloc = b.st[0], nx = b.st[1];
        if (nloc == 0u) { unsigned reg; xcd_barrier_complete(bar, bx_, nloc, nx, reg); b.st[0] = nloc; b.st[1] = nx; b.st[2] = reg; }
        const unsigned old = xb_add(&bar[XB_XSUB(bx_)], 1u);
        const unsigned gen = old / nloc;
        if (old + 1u == (gen + 1u) * nloc) {
            __builtin_amdgcn_fence(__ATOMIC_RELEASE, "agent");
            asm volatile("s_waitcnt vmcnt(0)" ::: "memory");
            const unsigned og = xb_add(&bar[XB_TOP], 1u);
            const unsigned tg = og / nx;
            if (og + 1u == (tg + 1u) * nx) xb_add(&bar[XB_TOPGEN], 1u);
            else XB_SPIN(xb_ld(&bar[XB_TOPGEN]) == tg, bar);
            __builtin_amdgcn_fence(__ATOMIC_ACQUIRE, "agent");
            xb_add(&bar[XB_XGEN(bx_)], 1u);
            asm volatile("s_waitcnt vmcnt(0)" ::: "memory");
        } else {
            XB_SPIN(xb_ld(&bar[XB_XGEN(bx_)]) == gen, bar);
            __builtin_amdgcn_fence(__ATOMIC_ACQUIRE, "agent");
            asm volatile("s_waitcnt vmcnt(0)" ::: "memory");
        }
    }
    __syncthreads();
}

__device__ __forceinline__ void xcd_local_barrier(const XcdBarrier& b) {
    asm volatile("s_waitcnt vmcnt(0)" ::: "memory");
    __syncthreads();
    if (threadIdx.x == 0) {
        unsigned* bar = b.bar; unsigned bx_ = b.x; asm volatile("" : "+s"(bar), "+s"(bx_));
        __builtin_amdgcn_s_waitcnt(0);
        const unsigned nloc = b.st[0];
        const unsigned old = xb_add(&bar[XB_XSUB(bx_)], 1u);
        const unsigned gen = old / nloc;
        if (old + 1u == (gen + 1u) * nloc) xb_add(&bar[XB_XGEN(bx_)], 1u);
        else XB_SPIN(xb_ld(&bar[XB_XGEN(bx_)]) == gen, bar);
        __builtin_amdgcn_fence(__ATOMIC_ACQUIRE, "agent");
        asm volatile("s_waitcnt vmcnt(0)" ::: "memory");
    }
    __syncthreads();
}
constexpr int NWAVES = 8;
constexpr int DM_ = 1024, NBATCH = 8, SEQ_ = 2048, M_ = NBATCH * SEQ_;
constexpr size_t MiB = 1u << 20;
constexpr size_t WS_CTL = 0, CTL_ZERO_BYTES = 32 * 1024;
constexpr size_t WS_W0IN = 2 * MiB, WS_W0OUT = 14 * MiB, WS_W1IN = 18 * MiB, WS_W1OUT = 24 * MiB, WS_W2IN = 27 * MiB, WS_W2OUT = 35 * MiB, WS_W3IN = 37 * MiB, WS_W3OUT = 49 * MiB;
constexpr size_t WS_WF = 53 * MiB;
constexpr size_t WS_WAT = 53 * MiB + 64 * 1024, WS_WXT = WS_WAT + 512 * 1024;
constexpr size_t WS_SSQ = 60 * MiB;
constexpr size_t WS_LOGF = 60 * MiB + 512 * 1024;
constexpr size_t WS_VSSQ = 62 * MiB;
constexpr size_t WS_SUMM = 62 * MiB;
constexpr size_t WS_XB = 64 * MiB;
constexpr size_t WS_ACT = 96 * MiB;
constexpr size_t WS_UG = WS_ACT, WS_GV = WS_ACT + 64 * MiB;
constexpr size_t WS_XBR = WS_ACT, WS_LSG = WS_ACT + 48 * MiB, WS_LY = WS_ACT + 96 * MiB;
constexpr size_t WS_Q = WS_ACT, WS_K = WS_ACT + 32 * MiB, WS_V = WS_ACT + 64 * MiB, WS_FSG = WS_ACT + 96 * MiB;
constexpr size_t ARENA_BYTES = 20 * MiB;
constexpr size_t WS_END = 256 * MiB;
constexpr int CW_BAR = 4096; static_assert((CW_BAR + 3456) * 4 <= (int)CTL_ZERO_BYTES, "barrier words inside the per-call memset");
constexpr int RING_BYTES = 131072, LDSCTL_OFF = RING_BYTES, MISC_OFF = LDSCTL_OFF + 320, LDS_BYTES = 147456;

typedef float f32x16 __attribute__((ext_vector_type(16)));
typedef short s16x4 __attribute__((ext_vector_type(4)));
__device__ __forceinline__ unsigned cvtpk(float lo, float hi) { return pg8::cvt_pk_bf16(lo, hi); }
__device__ __forceinline__ float bflo(unsigned u) { return __uint_as_float(u << 16); }
__device__ __forceinline__ float bfhi(unsigned u) { return __uint_as_float(u & 0xffff0000u); }

#define LDS_BARRIER() do { asm volatile("s_waitcnt lgkmcnt(0)" ::: "memory"); __builtin_amdgcn_s_barrier(); asm volatile("" ::: "memory"); } while (0)

__device__ __forceinline__ void tr_item(const float* W, int K, int ldw, const float* gain, bf16* WT, LAS float* scr, int kb, int nb, int scol, int lane) {
    const int k0 = 64 * kb, n0 = 32 * nb;
    { const int n4 = (lane & 7) * 4, kr = lane >> 3; f32x4 v[8];
#pragma unroll
      for (int i = 0; i < 8; ++i) v[i] = __builtin_nontemporal_load((const f32x4*)(W + (size_t)(k0 + 8 * i + kr) * ldw + scol + n4));
#pragma unroll
      for (int i = 0; i < 8; ++i) { const int kk = 8 * i + kr; const float g = gain ? gain[k0 + kk] : 1.0f; LAS float* d = scr + kk * 33 + n4; d[0] = v[i][0] * g; d[1] = v[i][1] * g; d[2] = v[i][2] * g; d[3] = v[i][3] * g; } }
    LDS_WAIT(); asm volatile("" ::: "memory");
    const int c = lane & 7;
#pragma unroll
    for (int j = 0; j < 4; ++j) { const int n = (lane >> 3) + 8 * j; const LAS float* s = scr + (8 * c) * 33 + n;
        v4u o; o.x = cvtpk(s[0 * 33], s[1 * 33]); o.y = cvtpk(s[2 * 33], s[3 * 33]); o.z = cvtpk(s[4 * 33], s[5 * 33]); o.w = cvtpk(s[6 * 33], s[7 * 33]);
        *(v4u*)(WT + (size_t)(n0 + n) * K + k0 + 8 * c) = o; }
    LDS_WAIT(); asm volatile("" ::: "memory");
}
__device__ __forceinline__ int scol_gmlp(int nb) { const int n = nb * 32, pn = n >> 8, w = n & 255; if (pn < 16) return (w < 128) ? pn * 128 + w : 4096 + pn * 128 + (w - 128); return 2048 + (pn - 16) * 256 + w; }
__device__ __forceinline__ int scol_fox(int nb) { const int n = nb * 32, pn = n >> 8, w = n & 255; if (pn < 8) { const int bj = w >> 7, wc = (w >> 5) & 3; return (pn < 4 ? 0 : 1024) + 64 * (4 * (pn & 3) + wc) + 32 * bj; } return n; }

template <int PART, class A> __device__ __forceinline__ void p0_weights(const A& args, unsigned char* ws, LAS unsigned char* lds, int gw, int NGW, int lane, int wave) {
    LAS float* scr = (LAS float*)(lds + wave * 16384);
    int joff = 0;
#define P0_JOB(Wp, Gp, WTo, K_, LDW_, NBLK_, MAP_) do { const float* W_ = (Wp); const float* G_ = (Gp); bf16* WT_ = (bf16*)(ws + (WTo)); const int nit = ((K_) / 64) * (NBLK_); \
        int it0_ = (gw - joff) % NGW; if (it0_ < 0) it0_ += NGW; joff = (joff + nit) % NGW;     \
        for (int it = it0_; it < nit; it += NGW) { const int kb = it / (NBLK_), nb = it % (NBLK_); const int sc = (MAP_) == 1 ? scol_gmlp(nb) : ((MAP_) == 2 ? scol_fox(nb) : nb * 32); \
            tr_item(W_, (K_), (LDW_), G_, WT_, scr, kb, nb, sc, lane); } } while (0)
    if (PART == 0) {
    P0_JOB(args.in[2], args.in[1], WS_W0IN, 1024, 6144, 192, 1);
    P0_JOB(args.in[6], (const float*)nullptr, WS_W0OUT, 2048, 1024, 32, 0);
    P0_JOB(args.in[8], args.in[7], WS_W1IN, 1024, 3072, 96, 0);
    } else {
    P0_JOB(args.in[16], (const float*)nullptr, WS_W1OUT, 1536, 1024, 32, 0);
    P0_JOB(args.in[18], args.in[17], WS_W2IN, 1024, 4112, 128, 2);
    P0_JOB(args.in[22], (const float*)nullptr, WS_W2OUT, 1024, 1024, 32, 0);
    P0_JOB(args.in[24], args.in[23], WS_W3IN, 1024, 6144, 192, 1);
    P0_JOB(args.in[28], (const float*)nullptr, WS_W3OUT, 2048, 1024, 32, 0);
    }
#undef P0_JOB
    const int gt = gw * 64 + lane, NGT = NGW * 64;
    if (PART == 1) { const float* W = args.in[18]; const float* g = args.in[17]; bf16* WF = (bf16*)(ws + WS_WF);
      for (int i = gt; i < 16 * 1024; i += NGT) { const int hc = i >> 10, k = i & 1023; WF[i] = (bf16)f2bf(g[k] * W[(size_t)k * 4112 + 4096 + hc]); } }
    if (PART == 0) { const float* wa = args.in[11]; const float* wx = args.in[13]; bf16* WAT = (bf16*)(ws + WS_WAT); bf16* WXT = (bf16*)(ws + WS_WXT);
      for (int i = gt; i < 16 * 96 * 96; i += NGT) { const int h = i / 9216, rem = i % 9216, jj = rem / 96, ii = rem % 96; const size_t s = (size_t)h * 9216 + ii * 96 + jj;
          WAT[i] = (bf16)f2bf(wa[s]); WXT[i] = (bf16)f2bf(wx[s]); } }
}
__device__ __forceinline__ void p_prep(const float* x, bf16* XB, float* ssq, int gw, int NGW, int lane) {
    for (int m = gw; m < M_; m += NGW) {
        const f32x4* xr = (const f32x4*)(x + (size_t)m * DM_) + lane; f32x4 v[4]; float s = 0.f;
#pragma unroll
        for (int j = 0; j < 4; ++j) { v[j] = __builtin_nontemporal_load(xr + 64 * j); s += (v[j][0] * v[j][0] + v[j][1] * v[j][1]) + (v[j][2] * v[j][2] + v[j][3] * v[j][3]); }
#pragma unroll
        for (int o = 1; o < 64; o <<= 1) s += __shfl_xor(s, o);
        unsigned long long* o8 = (unsigned long long*)(XB + (size_t)m * DM_) + lane;
#pragma unroll
        for (int j = 0; j < 4; ++j) o8[64 * j] = (unsigned long long)cvtpk(v[j][0], v[j][1]) | ((unsigned long long)cvtpk(v[j][2], v[j][3]) << 32);
        if (lane == 0) *(f32x4*)(ssq + (size_t)m * 4) = (f32x4){s, 0.f, 0.f, 0.f};
    }
}

constexpr int MIX_RS_OFF = RING_BYTES + 512;
struct MixPre { v4u gv[8]; float rs; };
__device__ __forceinline__ void mix_load(MixPre& P, int ch, int g, const bf16* GV, const bf16* UGY, const float* vssq, int tid) {
    const int r0 = ch * 128, c0 = g * 256;
    f32x4 vs[8];
    if (tid < 128) { const f32x4* p = (const f32x4*)(vssq + (size_t)(r0 + tid) * 32);
#pragma unroll
        for (int i = 0; i < 8; ++i) vs[i] = p[i]; }
#pragma unroll
    for (int i = 0; i < 8; ++i) { const int s = (tid >> 5) + 16 * i, cc = tid & 31; P.gv[i] = __builtin_nontemporal_load((const v4u*)(GV + (size_t)(r0 + s) * 2048 + c0 + cc * 8)); }
    P.rs = 0.f;
    if (tid < 128) { float s = 0.f;
#pragma unroll
        for (int i = 0; i < 8; ++i) s += (vs[i][0] + vs[i][1]) + (vs[i][2] + vs[i][3]);
        P.rs = rsqrtf(s * (1.0f / 2048.0f) + 1e-6f); }
}
__device__ __forceinline__ void mix_stage(const MixPre& P, LAS unsigned char* tile, LAS float* RS, int tid) {
    if (tid < 128) RS[tid] = P.rs;
    LDS_BARRIER();
#pragma unroll
    for (int i = 0; i < 8; ++i) { const int s = (tid >> 5) + 16 * i, cc = tid & 31; const float r = RS[s]; const v4u v = P.gv[i]; v4u o;
        o.x = cvtpk(bflo(v.x) * r, bfhi(v.x) * r); o.y = cvtpk(bflo(v.y) * r, bfhi(v.y) * r); o.z = cvtpk(bflo(v.z) * r, bfhi(v.z) * r); o.w = cvtpk(bflo(v.w) * r, bfhi(v.w) * r);
        *(LAS v4u*)(tile + (cc >> 2) * 8192 + s * 64 + (cc & 3) * 16) = o; }
}
__device__ __forceinline__ void mix_compute(const LAS unsigned char* tile, const bf16x8 (&bw)[4][2], const float (&btv)[2], int ch, int g, bf16* UGY, const LAS float* v_norm, int lane, int wid) {
    const int r0 = ch * 128, c0 = g * 256;
    const int tb = wid >> 1, dh = wid & 1, fr = lane & 15, fq = lane >> 4;
    v4u ugv[2][4];
#pragma unroll
    for (int tt = 0; tt < 2; ++tt)
#pragma unroll
        for (int pp = 0; pp < 4; ++pp) ugv[tt][pp] = __builtin_nontemporal_load((const v4u*)(UGY + (size_t)(r0 + 32 * tb + 16 * tt + fr) * 2048 + c0 + 128 * dh + 32 * pp + 8 * fq));
    f32x4 acc[2][4][2];
#pragma unroll
    for (int a = 0; a < 2; ++a)
#pragma unroll
        for (int b = 0; b < 4; ++b)
#pragma unroll
            for (int n = 0; n < 2; ++n) acc[a][b][n] = (f32x4){0.f, 0.f, 0.f, 0.f};
#pragma unroll
    for (int ks = 0; ks < 4; ++ks) { if (ks <= tb) {
        const LAS unsigned char* ab = tile + (4 * dh) * 8192 + (32 * ks + 8 * fq + ((lane & 15) >> 2)) * 64 + (lane & 3) * 16;
#pragma unroll
        for (int pp = 0; pp < 4; ++pp)
#pragma unroll
            for (int n = 0; n < 2; ++n) { const LAS unsigned char* ap = ab + pp * 8192 + n * 8;
                const s16x4 lo = __builtin_bit_cast(s16x4, __builtin_amdgcn_ds_read_tr16_b64_v4i16((LAS s16x4*)ap));
                const s16x4 hi = __builtin_bit_cast(s16x4, __builtin_amdgcn_ds_read_tr16_b64_v4i16((LAS s16x4*)(ap + 4 * 64)));
                const bf16x8 a = (bf16x8){lo[0], lo[1], lo[2], lo[3], hi[0], hi[1], hi[2], hi[3]};
#pragma unroll
                for (int tt = 0; tt < 2; ++tt) acc[tt][pp][n] = __builtin_amdgcn_mfma_f32_16x16x32_bf16(a, bw[ks][tt], acc[tt][pp][n], 0, 0, 0); }
    } }
#pragma unroll
    for (int tt = 0; tt < 2; ++tt) { const int tl = 32 * tb + 16 * tt + fr; const float bt = btv[tt];
#pragma unroll
        for (int pp = 0; pp < 4; ++pp) { const int col = c0 + 128 * dh + 32 * pp + 8 * fq; bf16* p = UGY + (size_t)(r0 + tl) * 2048 + col;
            const v4u ug = ugv[tt][pp]; const f32x4 n0 = *(const LAS f32x4*)(v_norm + col), n1 = *(const LAS f32x4*)(v_norm + col + 4);
            const f32x4 a0 = acc[tt][pp][0], a1 = acc[tt][pp][1]; v4u o;
            o.x = cvtpk(bflo(ug.x) * (n0[0] * a0[0] + bt), bfhi(ug.x) * (n0[1] * a0[1] + bt)); o.y = cvtpk(bflo(ug.y) * (n0[2] * a0[2] + bt), bfhi(ug.y) * (n0[3] * a0[3] + bt));
            o.z = cvtpk(bflo(ug.z) * (n1[0] * a1[0] + bt), bfhi(ug.z) * (n1[1] * a1[1] + bt)); o.w = cvtpk(bflo(ug.w) * (n1[2] * a1[2] + bt), bfhi(ug.w) * (n1[3] * a1[3] + bt));
            *(v4u*)p = o; } }
}
__device__ __forceinline__ void mix_phase(LAS unsigned char* lds, int k, int g, int n, const bf16* GV, bf16* UGY, const float* vssq, const float* w_s, const float* b_s, const float* v_norm, int tid, int lane, int wid) {
    LAS float* RS = (LAS float*)(lds + MIX_RS_OFF); LAS float* VN = (LAS float*)(lds + MIX_RS_OFF + 1024);
    *(LAS f32x4*)(VN + 4 * tid) = *(const f32x4*)(v_norm + 4 * tid);
    const int tb = wid >> 1, fr = lane & 15, fq = lane >> 4;
    MixPre P;

    if (n > 0) mix_load(P, 4 * k, g, GV, UGY, vssq, tid);
    bf16x8 bw[4][2]; float btv[2];
    { f32x4 wv[4][2][2];
#pragma unroll
      for (int tt = 0; tt < 2; ++tt) { const int t = 32 * tb + 16 * tt + fr; btv[tt] = b_s[g * 128 + t];
#pragma unroll
        for (int ks = 0; ks < 4; ++ks) { const float* wp = w_s + ((size_t)g * 128 + t) * 128 + 32 * ks + 8 * fq;
            if (ks <= tb) { wv[ks][tt][0] = *(const f32x4*)wp; wv[ks][tt][1] = *(const f32x4*)(wp + 4); } else { wv[ks][tt][0] = (f32x4){0.f, 0.f, 0.f, 0.f}; wv[ks][tt][1] = (f32x4){0.f, 0.f, 0.f, 0.f}; } } }
#pragma unroll
      for (int ks = 0; ks < 4; ++ks) { const int s0 = 32 * ks + 8 * fq;
#pragma unroll
        for (int tt = 0; tt < 2; ++tt) { const int t = 32 * tb + 16 * tt + fr; const f32x4 w0 = wv[ks][tt][0], w1 = wv[ks][tt][1]; float e[8];
#pragma unroll
            for (int j = 0; j < 4; ++j) { e[j] = (s0 + j <= t) ? w0[j] : 0.f; e[4 + j] = (s0 + 4 + j <= t) ? w1[j] : 0.f; }
            v4u pk; pk.x = cvtpk(e[0], e[1]); pk.y = cvtpk(e[2], e[3]); pk.z = cvtpk(e[4], e[5]); pk.w = cvtpk(e[6], e[7]);
            bw[ks][tt] = __builtin_bit_cast(bf16x8, pk); } } }
    if (n > 0) mix_stage(P, lds, RS, tid);
    LDS_BARRIER();

    for (int i = 0; i < n; ++i) { const int buf = i & 1;

        if (i + 1 < n) mix_load(P, 4 * k + i + 1, g, GV, UGY, vssq, tid);

        mix_compute(lds + buf * 65536, bw, btv, 4 * k + i, g, UGY, VN, lane, wid);

        if (i + 1 < n) mix_stage(P, lds + (buf ^ 1) * 65536, RS, tid);

        LDS_BARRIER(); }
}

__device__ __forceinline__ void mix_phase_w(LAS unsigned char* lds, int ch0, int g, int n, const bf16* GV, bf16* UGY, const float* vssq, const float* w_s, const float* b_s, const float* v_norm, int tid, int lane, int wid) {
    LAS float* RS = (LAS float*)(lds + MIX_RS_OFF);
    { const int it = tid >> 7, s = tid & 127;
      if (it < n) { const f32x4* p = (const f32x4*)(vssq + (size_t)((ch0 + it) * 128 + s) * 32); float sum = 0.f;
#pragma unroll
        for (int i = 0; i < 8; ++i) { const f32x4 v = p[i]; sum += (v[0] + v[1]) + (v[2] + v[3]); }
        RS[tid] = rsqrtf(sum * (1.0f / 2048.0f) + 1e-6f); } }
    const int fr = lane & 15, fq = lane >> 4, cw = g * 256 + 32 * wid;
    LAS unsigned char* WL = lds + 65536;
    { const int t = tid >> 2, sb = (tid & 3) * 32; const float* wp = w_s + ((size_t)g * 128 + t) * 128 + sb;
#pragma unroll
      for (int q = 0; q < 4; ++q) { const f32x4 w0 = *(const f32x4*)(wp + 8 * q), w1 = *(const f32x4*)(wp + 8 * q + 4); const int s0 = sb + 8 * q; float e[8];
#pragma unroll
        for (int z = 0; z < 4; ++z) { e[z] = (s0 + z <= t) ? w0[z] : 0.f; e[4 + z] = (s0 + 4 + z <= t) ? w1[z] : 0.f; }
        v4u pk; pk.x = cvtpk(e[0], e[1]); pk.y = cvtpk(e[2], e[3]); pk.z = cvtpk(e[4], e[5]); pk.w = cvtpk(e[6], e[7]);
        *(LAS v4u*)(WL + t * 272 + (s0 * 2)) = pk; } }
    float btv[8];
#pragma unroll
    for (int jj = 0; jj < 8; ++jj) btv[jj] = b_s[g * 128 + 16 * jj + fr];
    const f32x4 n0 = *(const f32x4*)(v_norm + cw + 8 * fq), n1 = *(const f32x4*)(v_norm + cw + 8 * fq + 4);
    LDS_BARRIER();
    LAS unsigned char* tile = lds + wid * 8192;
    v4u gvv[8];
#define MIXW_LOADGV(i_) do { const int rr_ = (ch0 + ((i_) < n ? (i_) : n - 1)) * 128; _Pragma("unroll") for (int k = 0; k < 8; ++k) gvv[k] = *(const v4u*)(GV + (size_t)(rr_ + (lane >> 2) + 16 * k) * 2048 + cw + 8 * (lane & 3)); } while (0)
    MIXW_LOADGV(0);
#pragma unroll 1
    for (int i = 0; i < n; ++i) { const int r0 = (ch0 + i) * 128;
        v4u ugv[8];
#pragma unroll
        for (int j = 0; j < 8; ++j) ugv[j] = *(const v4u*)(UGY + (size_t)(r0 + 16 * j + fr) * 2048 + cw + 8 * fq);
#pragma unroll
        for (int k = 0; k < 8; ++k) { const int s = (lane >> 2) + 16 * k; const float r = RS[i * 128 + s]; const v4u v = gvv[k]; v4u o;
            o.x = cvtpk(bflo(v.x) * r, bfhi(v.x) * r); o.y = cvtpk(bflo(v.y) * r, bfhi(v.y) * r); o.z = cvtpk(bflo(v.z) * r, bfhi(v.z) * r); o.w = cvtpk(bflo(v.w) * r, bfhi(v.w) * r);
            *(LAS v4u*)(tile + s * 64 + (lane & 3) * 16) = o; }
        MIXW_LOADGV(i + 1);
        f32x4 acc[8][2];
#pragma unroll
        for (int j = 0; j < 8; ++j) { acc[j][0] = (f32x4){0.f, 0.f, 0.f, 0.f}; acc[j][1] = (f32x4){0.f, 0.f, 0.f, 0.f}; }
#pragma unroll
        for (int ks = 0; ks < 4; ++ks) { const LAS unsigned char* ab = tile + (32 * ks + 8 * fq + (fr >> 2)) * 64 + (lane & 3) * 16; bf16x8 a[2];
#pragma unroll
            for (int nn = 0; nn < 2; ++nn) { const LAS unsigned char* ap = ab + nn * 8;
                const s16x4 lo = __builtin_bit_cast(s16x4, __builtin_amdgcn_ds_read_tr16_b64_v4i16((LAS s16x4*)ap));
                const s16x4 hi = __builtin_bit_cast(s16x4, __builtin_amdgcn_ds_read_tr16_b64_v4i16((LAS s16x4*)(ap + 4 * 64)));
                a[nn] = (bf16x8){lo[0], lo[1], lo[2], lo[3], hi[0], hi[1], hi[2], hi[3]}; }
#pragma unroll
            for (int j = 2 * ks; j < 8; ++j) { const bf16x8 b = *(const LAS bf16x8*)(WL + (16 * j + fr) * 272 + (32 * ks + 8 * fq) * 2);
                acc[j][0] = __builtin_amdgcn_mfma_f32_16x16x32_bf16(a[0], b, acc[j][0], 0, 0, 0); acc[j][1] = __builtin_amdgcn_mfma_f32_16x16x32_bf16(a[1], b, acc[j][1], 0, 0, 0); } }
#pragma unroll
        for (int j = 0; j < 8; ++j) { const float bt = btv[j]; bf16* p = UGY + (size_t)(r0 + 16 * j + fr) * 2048 + cw + 8 * fq; const v4u ug = ugv[j]; const f32x4 a0 = acc[j][0], a1 = acc[j][1]; v4u o;
            o.x = cvtpk(bflo(ug.x) * (n0[0] * a0[0] + bt), bfhi(ug.x) * (n0[1] * a0[1] + bt)); o.y = cvtpk(bflo(ug.y) * (n0[2] * a0[2] + bt), bfhi(ug.y) * (n0[3] * a0[3] + bt));
            o.z = cvtpk(bflo(ug.z) * (n1[0] * a1[0] + bt), bfhi(ug.z) * (n1[1] * a1[1] + bt)); o.w = cvtpk(bflo(ug.w) * (n1[2] * a1[2] + bt), bfhi(ug.w) * (n1[3] * a1[3] + bt));
            *(v4u*)p = o; }
    }
#undef MIXW_LOADGV
}

constexpr int RSTD_TAB_OFF = RING_BYTES + 1024;
template <class Sched> __device__ __forceinline__ void rstd_table(LAS unsigned char* lds, const Sched& S, const float* ssq, int tid) {
    LAS float* RT = (LAS float*)(lds + RSTD_TAB_OFF); pg8::Unit u;
    for (int i = 0; S.next(i, u); ++i) if (tid < 256) RT[i * 256 + tid] = pg8::row_rstd(ssq, u.pm * 256 + tid);
    __syncthreads();
}

__device__ __forceinline__ void flogit_phase(const bf16* XB, const bf16* WF, const float* ssq, const float* b_f, float* LOGF, int vcu, int G, int wid, int lane) {
    if (wid >= 4) return;
    for (int tile = vcu * 4 + wid; tile < M_ / 16; tile += G * 4) {
        const int row0 = tile * 16; f32x4 acc = (f32x4){0.f, 0.f, 0.f, 0.f};
        const bf16* ap = XB + (size_t)(row0 + (lane & 15)) * 1024 + 8 * (lane >> 4); const bf16* bp = WF + (size_t)(lane & 15) * 1024 + 8 * (lane >> 4);
#pragma unroll
        for (int kk = 0; kk < 32; ++kk) { const bf16x8 a = *(const bf16x8*)(ap + 32 * kk), b = *(const bf16x8*)(bp + 32 * kk); acc = __builtin_amdgcn_mfma_f32_16x16x32_bf16(a, b, acc, 0, 0, 0); }
        const float bf = b_f[lane & 15]; f32x4 lf4;
#pragma unroll
        for (int r = 0; r < 4; ++r) { const int row = row0 + 4 * (lane >> 4) + r; const float x = acc[r] * pg8::row_rstd(ssq, row) + bf;
            lf4[r] = fminf(x, 0.f) - 0.69314718056f * __builtin_amdgcn_logf(1.0f + __builtin_amdgcn_exp2f(-1.4426950409f * fabsf(x))); }
        { const int row = row0 + 4 * (lane >> 4); *(f32x4*)(LOGF + ((size_t)(row >> 11) * 16 + (lane & 15)) * 2048 + (row & 2047)) = lf4; }
    }
}
constexpr int L_XS = 0, L_STG = 0, L_XC = 49728, L_CW = 102976, L_WSUM = 104896, L_HIN = 107968, L_WB = 108416, L_RS = 208;
__device__ __forceinline__ void lru_item(LAS unsigned char* lds, int b, int h, int hf, const bf16* XBR, const bf16* SG, bf16* Y, const bf16* WAT, const bf16* WXT,
                                         const float* conv_w, const float* conv_b, const float* b_a, const float* b_x, const float* lam, int tid, int lane, int wid) {
    const size_t rowb = (size_t)b * SEQ_;
    const int c16 = lane & 15, fq = lane >> 4;
    for (int i = tid; i < 480; i += 512) { const int w = i / 96, cch = i % 96; ((LAS float*)(lds + L_CW))[i] = (w < 4) ? conv_w[w * 1536 + h * 96 + cch] : conv_b[h * 96 + cch]; }
    if (tid < 96) ((LAS float*)(lds + L_HIN))[tid] = 0.f;
    for (int p = tid; p < 1152; p += 512) { const int mat = p / 576, rem = p % 576, row = rem / 12, cc = rem % 12;
        *(LAS v4u*)(lds + L_WB + (mat * 48 + row) * L_RS + cc * 16) = *(const v4u*)((mat ? WXT : WAT) + ((size_t)h * 96 + 48 * hf + row) * 96 + cc * 8); }
    float cbA[3], cbX[3], c8l[3];
#pragma unroll
    for (int nt = 0; nt < 3; ++nt) { const int ch = h * 96 + 48 * hf + 16 * nt + c16;
        cbA[nt] = -1.4426950409f * b_a[ch]; cbX[nt] = -1.4426950409f * b_x[ch]; c8l[nt] = -8.0f * 1.4426950409f * log1pf(__expf(-lam[ch])); }
    v4u xs[10], sgr[3];
#define LRU_LOADX(tl_, tid_) do { const int tc_ = (tid_) < 444 ? (tid_) : 443; const int c_ = tc_ % 12, tg_ = tc_ / 12; _Pragma("unroll") for (int i = 0; i < 10; ++i) { int tok = (tl_) * 256 - 3 + 7 * tg_ + i; tok = tok < 0 ? 0 : (tok > 2047 ? 2047 : tok); \
        xs[i] = *(const v4u*)(XBR + (rowb + tok) * 1536 + h * 96 + 8 * c_); } } while (0)
    LRU_LOADX(0, tid);
    LDS_BARRIER();
#pragma unroll 1
    for (int tl = 0; tl < 8; ++tl) {
        const int t0 = tl * 256; int tq = tid; asm volatile("" : "+v"(tq));
        if (tq < 444) { const int c = tq % 12, tg = tq / 12; const LAS float* cw = (const LAS float*)(lds + L_CW) + 8 * c;
            if (tl == 0 && tg == 0) { xs[0] = (v4u){0u, 0u, 0u, 0u}; xs[1] = (v4u){0u, 0u, 0u, 0u}; xs[2] = (v4u){0u, 0u, 0u, 0u}; }
            typedef float f32x2_ __attribute__((ext_vector_type(2)));
            f32x2_ wv[4][4], bv[4];
#pragma unroll
            for (int w = 0; w < 4; ++w) { const f32x4 w0 = *(const LAS f32x4*)(cw + 96 * w), w1 = *(const LAS f32x4*)(cw + 96 * w + 4);
                wv[w][0] = (f32x2_){w0[0], w0[1]}; wv[w][1] = (f32x2_){w0[2], w0[3]}; wv[w][2] = (f32x2_){w1[0], w1[1]}; wv[w][3] = (f32x2_){w1[2], w1[3]}; }
            { const f32x4 b0 = *(const LAS f32x4*)(cw + 384), b1 = *(const LAS f32x4*)(cw + 388); bv[0] = (f32x2_){b0[0], b0[1]}; bv[1] = (f32x2_){b0[2], b0[3]}; bv[2] = (f32x2_){b1[0], b1[1]}; bv[3] = (f32x2_){b1[2], b1[3]}; }
            f32x2_ ux[10][4];
#pragma unroll
            for (int r = 0; r < 10; ++r) { const v4u xv = xs[r]; ux[r][0] = (f32x2_){bflo(xv.x), bfhi(xv.x)}; ux[r][1] = (f32x2_){bflo(xv.y), bfhi(xv.y)}; ux[r][2] = (f32x2_){bflo(xv.z), bfhi(xv.z)}; ux[r][3] = (f32x2_){bflo(xv.w), bfhi(xv.w)}; }
#pragma unroll
            for (int k = 0; k < 7; ++k) { const int t = 7 * tg + k;
                if (t < 256) { f32x2_ a[4] = {bv[0], bv[1], bv[2], bv[3]};
#pragma unroll
                    for (int w = 0; w < 4; ++w)
#pragma unroll
                        for (int p = 0; p < 4; ++p) a[p] = __builtin_elementwise_fma(wv[w][p], ux[k + w][p], a[p]);
                    v4u o; o.x = cvtpk(a[0][0], a[0][1]); o.y = cvtpk(a[1][0], a[1][1]); o.z = cvtpk(a[2][0], a[2][1]); o.w = cvtpk(a[3][0], a[3][1]);
                    *(LAS v4u*)(lds + L_XC + t * L_RS + c * 16) = o; } } }
        LDS_BARRIER();
        if (tl < 7) LRU_LOADX(tl + 1, tq);
#pragma unroll
        for (int i = 0; i < 3; ++i) { const int p = tq + 512 * i, t = p / 6, c6 = p % 6; sgr[i] = __builtin_nontemporal_load((const v4u*)(SG + (rowb + t0 + t) * 1536 + h * 96 + 48 * hf + 8 * c6)); }
        f32x4 accA[2][3], accX[2][3];
#pragma unroll
        for (int mt = 0; mt < 2; ++mt)
#pragma unroll
            for (int nt = 0; nt < 3; ++nt) { accA[mt][nt] = (f32x4){0.f, 0.f, 0.f, 0.f}; accX[mt][nt] = (f32x4){0.f, 0.f, 0.f, 0.f}; }
#pragma unroll
        for (int mt = 0; mt < 2; ++mt)
#pragma unroll
            for (int ks = 0; ks < 3; ++ks) { const bf16x8 a = *(const LAS bf16x8*)(lds + L_XC + (32 * wid + 16 * mt + c16) * L_RS + (32 * ks + 8 * fq) * 2);
#pragma unroll
                for (int nt = 0; nt < 3; ++nt) { const bf16x8 ba = *(const LAS bf16x8*)(lds + L_WB + (16 * nt + c16) * L_RS + (32 * ks + 8 * fq) * 2), bx = *(const LAS bf16x8*)(lds + L_WB + (48 + 16 * nt + c16) * L_RS + (32 * ks + 8 * fq) * 2);
                    accA[mt][nt] = __builtin_amdgcn_mfma_f32_16x16x32_bf16(a, ba, accA[mt][nt], 0, 0, 0); accX[mt][nt] = __builtin_amdgcn_mfma_f32_16x16x32_bf16(a, bx, accX[mt][nt], 0, 0, 0); } }
        float carP[3][2] = {{1.f, 1.f}, {1.f, 1.f}, {1.f, 1.f}}, carH[3][2] = {{0.f, 0.f}, {0.f, 0.f}, {0.f, 0.f}};
#pragma unroll
        for (int nt = 0; nt < 3; ++nt) {
            float Pg[2], Hg[2];
#pragma unroll
            for (int mt = 0; mt < 2; ++mt) {
#pragma unroll
                for (int r = 0; r < 4; ++r) { const int tloc = 32 * wid + 16 * mt + 4 * fq + r;
                    const float xcv = __uint_as_float((unsigned)(*(const LAS unsigned short*)(lds + L_XC + tloc * L_RS + (48 * hf + 16 * nt + c16) * 2)) << 16);
                    const float rg = __builtin_amdgcn_rcpf(1.0f + __builtin_amdgcn_exp2f(fmaf(accA[mt][nt][r], -1.4426950409f, cbA[nt])));
                    const float ig = __builtin_amdgcn_rcpf(1.0f + __builtin_amdgcn_exp2f(fmaf(accX[mt][nt][r], -1.4426950409f, cbX[nt])));
                    const float a = __builtin_amdgcn_exp2f(rg * c8l[nt]);
                    accA[mt][nt][r] = a; accX[mt][nt][r] = __builtin_amdgcn_sqrtf(fmaf(-a, a, 1.0f)) * (ig * xcv); }
                const float a0 = accA[mt][nt][0], a1 = accA[mt][nt][1], a2 = accA[mt][nt][2], a3 = accA[mt][nt][3];
                Pg[mt] = (a0 * a1) * (a2 * a3); Hg[mt] = ((accX[mt][nt][0] * a1 + accX[mt][nt][1]) * a2 + accX[mt][nt][2]) * a3 + accX[mt][nt][3]; }
            float cP = 1.0f, cH = 0.0f;
#pragma unroll
            for (int mt = 0; mt < 2; ++mt)
#pragma unroll
                for (int k = 0; k < 4; ++k) { const float P = __shfl(Pg[mt], c16 + 16 * k), H = __shfl(Hg[mt], c16 + 16 * k);
                    if (k == fq) { carP[nt][mt] = cP; carH[nt][mt] = cH; }
                    cP = cP * P; cH = cH * P + H; }
            if (fq == 0) { LAS float* ws = (LAS float*)(lds + L_WSUM) + (wid * 48 + 16 * nt + c16) * 2; ws[0] = cP; ws[1] = cH; }
        }
        LDS_BARRIER();
        {   const LAS float* hinb = (const LAS float*)(lds + L_HIN) + (tl & 1) * 48; LAS float* hout = (LAS float*)(lds + L_HIN) + ((tl & 1) ^ 1) * 48; LAS float* stg = (LAS float*)(lds + L_STG);
#pragma unroll
            for (int nt = 0; nt < 3; ++nt) { const int j = 16 * nt + c16; float hin = hinb[j];
                float sP[8], sH[8];
#pragma unroll
                for (int v = 0; v < 8; ++v) { const LAS float* ws = (const LAS float*)(lds + L_WSUM) + (v * 48 + j) * 2; sP[v] = ws[0]; sH[v] = ws[1]; }
#pragma unroll
                for (int v = 0; v < 8; ++v) { const float hn = hin * sP[v] + sH[v]; if (v == 7) { if (wid == 7 && fq == 0) hout[j] = hn; } else if (v < wid) hin = hn; }
#pragma unroll
                for (int mt = 0; mt < 2; ++mt) { float hs = hin * carP[nt][mt] + carH[nt][mt];
#pragma unroll
                    for (int r = 0; r < 4; ++r) { hs = accA[mt][nt][r] * hs + accX[mt][nt][r]; stg[(32 * wid + 16 * mt + 4 * fq + r) * 48 + j] = hs; } } }
        }
        LDS_BARRIER();
#pragma unroll
        for (int i = 0; i < 3; ++i) { const int p = tq + 512 * i, t = p / 6, c6 = p % 6; const LAS float* sp = (const LAS float*)(lds + L_STG) + t * 48 + 8 * c6;
            const f32x4 h0 = *(const LAS f32x4*)sp, h1 = *(const LAS f32x4*)(sp + 4); const v4u g = sgr[i]; v4u o;
            o.x = cvtpk(h0[0] * bflo(g.x), h0[1] * bfhi(g.x)); o.y = cvtpk(h0[2] * bflo(g.y), h0[3] * bfhi(g.y)); o.z = cvtpk(h1[0] * bflo(g.z), h1[1] * bfhi(g.z)); o.w = cvtpk(h1[2] * bflo(g.w), h1[3] * bfhi(g.w));
            *(v4u*)(Y + (rowb + t0 + t) * 1536 + h * 96 + 48 * hf + 8 * c6) = o; }
    }
#undef LRU_LOADX
}
#include <hip/hip_bf16.h>
namespace attn_body {
using bf16x8=__attribute__((ext_vector_type(8)))short;
using s16x4=__attribute__((ext_vector_type(4)))short;
using f32x16=__attribute__((ext_vector_type(16)))float;
using f32x4=__attribute__((ext_vector_type(4)))float;
using u32x4=__attribute__((ext_vector_type(4)))unsigned;
typedef unsigned short bf16;
constexpr int NHEAD=16,SEQ=2048,D=64,DM=NHEAD*D;
constexpr int NW=8,QBLK=32,QB=QBLK*NW,KVBLK=64,NQB=SEQ/QB;
__device__ __forceinline__ int crow(int r,int hi){return (r&3)+8*(r>>2)+4*hi;}
#define SBAR() __builtin_amdgcn_sched_barrier(0)
__device__ __forceinline__ void cmask(f32x16&p0,f32x16&p1,int jb,int qrel,int hi){
  const float NEG=-INFINITY; int kb=64*jb+4*hi;
  #pragma unroll
  for(int r=0;r<16;++r){int kv=kb+(r&3)+8*(r>>2); if(kv>qrel)p0[r]=NEG; if(kv+32>qrel)p1[r]=NEG;}
}
constexpr int NSLOT=3, SLOTB=8192;
constexpr int LDS_K=0, LDS_V=NSLOT*SLOTB, LDS_WS=2*NSLOT*SLOTB, LDS_OST=LDS_WS+NW*64*4, LDS_BT=LDS_OST+NW*8192, LDS_CUM=LDS_BT+NW*256, LDS_BYTES=LDS_CUM+SEQ*4;
constexpr float C2=0.125f*1.4426950408889634f;
__device__ __forceinline__ void glds16(const void*gsrc,unsigned lds_dst){unsigned keep;
  asm volatile("s_mov_b32 %0, m0\n\ts_mov_b32 m0, %2\n\ts_nop 0\n\tglobal_load_lds_dwordx4 %1, off\n\ts_mov_b32 m0, %0":"=&s"(keep):"v"(gsrc),"s"(lds_dst):"memory");}
typedef float f32x2_t __attribute__((ext_vector_type(2))); typedef __bf16 bf16x2_t __attribute__((ext_vector_type(2)));
__device__ __forceinline__ unsigned cvtpk_s(float lo,float hi){f32x2_t v={lo,hi};bf16x2_t b=__builtin_convertvector(v,bf16x2_t);return __builtin_bit_cast(unsigned,b);}
#define WAIT_BAR(N) asm volatile("s_waitcnt vmcnt(" #N ") lgkmcnt(0)\n\ts_barrier":::"memory")
typedef __attribute__((address_space(3))) const char* lds_cptr;
typedef __attribute__((address_space(3))) const float* lds_fptr;
typedef short v4i16_t __attribute__((ext_vector_type(4)));
typedef __attribute__((address_space(3))) float* lds_wfptr;
__device__ __forceinline__ void bias_init(f32x16&c0,f32x16&c1,lds_fptr cum,lds_wfptr bt,int t,int lane,int hi,float cwm){
  bt[lane]=cwm-cum[64*t+lane];
  const __attribute__((address_space(3))) f32x4* bp=(const __attribute__((address_space(3))) f32x4*)(bt+4*hi);
  #pragma unroll
  for(int g=0;g<4;++g){ const f32x4 a=bp[2*g]; const f32x4 b=bp[8+2*g];
    #pragma unroll
    for(int i=0;i<4;++i){ c0[4*g+i]=a[i]; c1[4*g+i]=b[i]; } }
}
__device__ __forceinline__ void qkt(f32x16&p0,f32x16&p1,const char*Kslot,const bf16x8*qr,int r32,int hi){
  const char*kb=Kslot+hi*1024+r32*16;
  #pragma unroll
  for(int d0=0;d0<4;++d0){
    const bf16x8 b0=*reinterpret_cast<const bf16x8*>(kb+d0*2048);
    const bf16x8 b1=*reinterpret_cast<const bf16x8*>(kb+d0*2048+512);
    p0=__builtin_amdgcn_mfma_f32_32x32x16_bf16(b0,qr[d0],p0,0,0,0);p1=__builtin_amdgcn_mfma_f32_32x32x16_bf16(b1,qr[d0],p1,0,0,0);}
}
__device__ __forceinline__ void kload8(bf16x8*kf,lds_cptr kp){
  kf[0]=*(const __attribute__((address_space(3))) bf16x8*)(kp);      kf[1]=*(const __attribute__((address_space(3))) bf16x8*)(kp+512);
  kf[2]=*(const __attribute__((address_space(3))) bf16x8*)(kp+2048); kf[3]=*(const __attribute__((address_space(3))) bf16x8*)(kp+2560);
  kf[4]=*(const __attribute__((address_space(3))) bf16x8*)(kp+4096); kf[5]=*(const __attribute__((address_space(3))) bf16x8*)(kp+4608);
  kf[6]=*(const __attribute__((address_space(3))) bf16x8*)(kp+6144); kf[7]=*(const __attribute__((address_space(3))) bf16x8*)(kp+6656);
}
__device__ __forceinline__ void kload2(bf16x8*kf,lds_cptr kp,int j){ kf[2*j]=*(const __attribute__((address_space(3))) bf16x8*)(kp+j*2048); kf[2*j+1]=*(const __attribute__((address_space(3))) bf16x8*)(kp+j*2048+512); }
__device__ __forceinline__ s16x4 vtr(lds_cptr p){ return __builtin_bit_cast(s16x4,__builtin_amdgcn_ds_read_tr16_b64_v4i16((__attribute__((address_space(3))) v4i16_t*)p)); }
__device__ __forceinline__ void pv(f32x16*o,int vb,bf16x8 pa0,bf16x8 pa1,bf16x8 pa2,bf16x8 pa3){
  #pragma unroll
  for(int d0=0;d0<2;++d0){s16x4 lo[4],hi[4];
    #pragma unroll
    for(int ks=0;ks<4;++ks){
      asm volatile("ds_read_b64_tr_b16 %0,%1 offset:%c2":"=&v"(lo[ks]):"v"(vb),"i"(d0*4096+ks*1024):"memory");
      asm volatile("ds_read_b64_tr_b16 %0,%1 offset:%c2":"=&v"(hi[ks]):"v"(vb),"i"(d0*4096+ks*1024+512):"memory");}
    asm volatile("s_waitcnt lgkmcnt(0)":::"memory");SBAR();
    #define PK(k) (bf16x8){lo[k][0],lo[k][1],lo[k][2],lo[k][3],hi[k][0],hi[k][1],hi[k][2],hi[k][3]}
    o[d0]=__builtin_amdgcn_mfma_f32_32x32x16_bf16(pa0,PK(0),o[d0],0,0,0);
    o[d0]=__builtin_amdgcn_mfma_f32_32x32x16_bf16(pa1,PK(1),o[d0],0,0,0);
    o[d0]=__builtin_amdgcn_mfma_f32_32x32x16_bf16(pa2,PK(2),o[d0],0,0,0);
    o[d0]=__builtin_amdgcn_mfma_f32_32x32x16_bf16(pa3,PK(3),o[d0],0,0,0);
    #undef PK
  }
}
__device__ __forceinline__ void attn_unit(int b,int h,int qb,const bf16*Q,const bf16*__restrict__ K,const bf16*__restrict__ V,const bf16*__restrict__ SG,bf16*O,char*shm,float mref,bf16x8 (&qr)[4],bool pre,int qb_next){
  int tid_=threadIdx.x; asm volatile("":"+v"(tid_)); const int tid=tid_,lane=tid&63,r32=lane&31,hi=lane>>5; const int wid=__builtin_amdgcn_readfirstlane(tid>>6);
  const long rowbase=(long)b*SEQ; const int q0=qb*QB;
  const bf16*Qw=Q+(rowbase+q0+wid*QBLK)*DM+h*D;
  const bf16*Kh=K+rowbase*DM+h*D,*Vh=V+rowbase*DM+h*D;
  const unsigned lds0=(unsigned)(uintptr_t)shm;
  const bf16*ksrc=Kh+(long)lane*DM+wid*8;
  const bf16*vsrc=Vh+(long)(16*(wid&3)+(lane>>2))*DM+(wid>>2)*32+(lane&3)*8;
  const unsigned kdst=lds0+LDS_K+wid*1024, vdst=lds0+LDS_V+wid*1024;
  #define DMA_K(t,slot) glds16(ksrc+(long)(t)*KVBLK*DM,(unsigned)__builtin_amdgcn_readfirstlane(kdst+(slot)))
  #define DMA_V(t,slot) glds16(vsrc+(long)(t)*KVBLK*DM,(unsigned)__builtin_amdgcn_readfirstlane(vdst+(slot)))
  const int vb0=(int)(lds0+LDS_V)+((lane>>4)&1)*32+(lane&3)*8+(4*hi+((lane&15)>>2))*64;
  const char*Kbase=shm+LDS_K; bf16x8 kf[8];
  const lds_cptr shm3=(lds_cptr)shm; const lds_cptr kp0=shm3+LDS_K+hi*1024+r32*16; const lds_cptr vp0=shm3+LDS_V+((lane>>4)&1)*32+(lane&3)*8+(4*hi+((lane&15)>>2))*64;
  const lds_fptr cum=(lds_fptr)(shm3+LDS_CUM);
  const int NT=(q0+QB)/KVBLK;
  if(!pre){ DMA_K(0,0);DMA_V(0,0);DMA_K(1,SLOTB);
  #pragma unroll
  for(int d0=0;d0<4;++d0)qr[d0]=*reinterpret_cast<const bf16x8*>(&Qw[(long)r32*DM+d0*16+hi*8]); }
  float l_reg=0.f;f32x16 o[2];o[0]=f32x16{};o[1]=f32x16{};
  const int qrel=wid*QBLK+r32;
  const float cwm=cum[q0+wid*QBLK+QBLK-1]-mref; const lds_wfptr bt=(lds_wfptr)(__attribute__((address_space(3))) char*)(shm3+LDS_BT)+wid*64;
  #define CMASK(P0,P1,t) do{int jb_=(t)-(NT-4); if(jb_>=0)cmask(P0,P1,jb_,qrel,hi);}while(0)
  f32x16 pA0,pA1,pB0,pB1;
  int sl_prev=0,sl_cur=0,sl_next=SLOTB;
  #define ROT() do{sl_prev=sl_cur;sl_cur=sl_next;sl_next=(sl_next==(NSLOT-1)*SLOTB)?0:sl_next+SLOTB;}while(0)
  DMA_K(2,2*SLOTB);
  bias_init(pA0,pA1,cum,bt,0,lane,hi,cwm);
  WAIT_BAR(3);
  qkt(pA0,pA1,Kbase,qr,r32,hi);CMASK(pA0,pA1,0);
  _Pragma("unroll") for(int r=0;r<16;++r){pA0[r]=__builtin_amdgcn_exp2f(pA0[r]);pA1[r]=__builtin_amdgcn_exp2f(pA1[r]);}
  WAIT_BAR(0);
  DMA_K(3,0);DMA_V(1,SLOTB);
  ROT();
  kload8(kf,kp0+sl_cur);
  WAIT_BAR(2);
  s16x4 vlo[8],vhi[8]; u32x4 pw0,pw1,pw2,pw3;
  #define PKW(P,B) cvtpk_s(P[B],P[B+1])
  #define PAF(k) __builtin_bit_cast(bf16x8,pw##k)
  #define VFR(i) (bf16x8){vlo[i][0],vlo[i][1],vlo[i][2],vlo[i][3],vhi[i][0],vhi[i][1],vhi[i][2],vhi[i][3]}
  #define PIN(x) asm volatile("":"+v"(x))
  #define GAPA(MF,A0,A1,A2,A3,W0,W1,PW) do{ MF; sacc+=A0; sacc+=A1; sacc+=A2; sacc+=A3; PIN(sacc); W0; W1; PIN(PW); SBAR(); }while(0)
  #define EX(v) __builtin_amdgcn_exp2f(v)
  #define GAPB(MF,X,B) do{ MF; X[B]=EX(X[B]); X[B+1]=EX(X[B+1]); X[B+2]=EX(X[B+2]); X[B+3]=EX(X[B+3]); PIN(X); SBAR(); }while(0)
  #define VRD(i) do{ vlo[i]=vtr(vp_+(((i)>>2)*4096+((i)&3)*1024)); vhi[i]=vtr(vp_+(((i)>>2)*4096+((i)&3)*1024+512)); }while(0)
  #define KRD(G,j) do{ if(G){ kload2(kf,kp0+sl_next,j); SBAR(); } }while(0)
  #define STEP(C0,C1,P0,P1,t,GK,GV,GL) do{ SBAR(); \
    bias_init(C0,C1,cum,bt,(t),lane,hi,cwm); SBAR(); \
    const lds_cptr vp_=vp0+sl_prev; \
    VRD(0); SBAR(); float sacc=(P0[0]+P0[1]); \
    GAPA(C0=__builtin_amdgcn_mfma_f32_32x32x16_bf16(kf[0],qr[0],C0,0,0,0), P0[2],P0[3],P0[4],P0[5],     pw0[0]=PKW(P0,0), pw0[1]=PKW(P0,2), pw0); \
    VRD(4); SBAR(); GAPA(C1=__builtin_amdgcn_mfma_f32_32x32x16_bf16(kf[1],qr[0],C1,0,0,0), P0[6],P0[7],P0[8],P0[9],     pw0[2]=PKW(P0,4), pw0[3]=PKW(P0,6), pw0); \
    VRD(1); SBAR(); GAPA(C0=__builtin_amdgcn_mfma_f32_32x32x16_bf16(kf[2],qr[1],C0,0,0,0),   P0[10],P0[11],P0[12],P0[13], pw1[0]=PKW(P0,8), pw1[1]=PKW(P0,10), pw1); \
    VRD(5); SBAR(); GAPA(C1=__builtin_amdgcn_mfma_f32_32x32x16_bf16(kf[3],qr[1],C1,0,0,0),   P0[14],P0[15],P1[0],P1[1],   pw1[2]=PKW(P0,12),pw1[3]=PKW(P0,14), pw1); \
    VRD(2); SBAR(); GAPA(C0=__builtin_amdgcn_mfma_f32_32x32x16_bf16(kf[4],qr[2],C0,0,0,0),   P1[2],P1[3],P1[4],P1[5],     pw2[0]=PKW(P1,0), pw2[1]=PKW(P1,2), pw2); \
    VRD(6); SBAR(); GAPA(C1=__builtin_amdgcn_mfma_f32_32x32x16_bf16(kf[5],qr[2],C1,0,0,0),   P1[6],P1[7],P1[8],P1[9],     pw2[2]=PKW(P1,4), pw2[3]=PKW(P1,6), pw2); \
    VRD(3); SBAR(); GAPA(C0=__builtin_amdgcn_mfma_f32_32x32x16_bf16(kf[6],qr[3],C0,0,0,0),   P1[10],P1[11],P1[12],P1[13], pw3[0]=PKW(P1,8), pw3[1]=PKW(P1,10), pw3); \
    VRD(7); SBAR(); GAPA(C1=__builtin_amdgcn_mfma_f32_32x32x16_bf16(kf[7],qr[3],C1,0,0,0),   P1[14],P1[15],0.f,0.f,       pw3[2]=PKW(P1,12),pw3[3]=PKW(P1,14), pw3); \
    l_reg+=sacc; \
    if(GK){DMA_K((t)+3,sl_cur);} if(GV){DMA_V((t)+1,sl_next);} \
    CMASK(C0,C1,t); \
    SBAR(); \
    GAPB(o[0]=__builtin_amdgcn_mfma_f32_32x32x16_bf16(PAF(0),VFR(0),o[0],0,0,0), C0,0); \
    GAPB(o[1]=__builtin_amdgcn_mfma_f32_32x32x16_bf16(PAF(0),VFR(4),o[1],0,0,0), C0,4); \
    KRD(GL,0); GAPB(o[0]=__builtin_amdgcn_mfma_f32_32x32x16_bf16(PAF(1),VFR(1),o[0],0,0,0), C0,8); \
    KRD(GL,1); GAPB(o[1]=__builtin_amdgcn_mfma_f32_32x32x16_bf16(PAF(1),VFR(5),o[1],0,0,0), C0,12); \
    KRD(GL,2); GAPB(o[0]=__builtin_amdgcn_mfma_f32_32x32x16_bf16(PAF(2),VFR(2),o[0],0,0,0), C1,0); \
    KRD(GL,3); GAPB(o[1]=__builtin_amdgcn_mfma_f32_32x32x16_bf16(PAF(2),VFR(6),o[1],0,0,0), C1,4); \
    GAPB(o[0]=__builtin_amdgcn_mfma_f32_32x32x16_bf16(PAF(3),VFR(3),o[0],0,0,0), C1,8); \
    GAPB(o[1]=__builtin_amdgcn_mfma_f32_32x32x16_bf16(PAF(3),VFR(7),o[1],0,0,0), C1,12); \
    }while(0)
  int t=1;
  #undef CMASK
  #define CMASK(P0,P1,t) do{}while(0)
  for(;t+5<NT;t+=2){
    STEP(pB0,pB1,pA0,pA1,t,true,true,true);     WAIT_BAR(2); ROT();
    STEP(pA0,pA1,pB0,pB1,t+1,true,true,true);   WAIT_BAR(2); ROT();
  }
  #undef CMASK
  #define CMASK(P0,P1,t) do{int jb_=(t)-(NT-4); if(jb_>=0)cmask(P0,P1,jb_,qrel,hi);}while(0)
  #define ENDW(tt) do{ if((tt)+3<NT){WAIT_BAR(2);} else if((tt)+2<NT){WAIT_BAR(1);} else {WAIT_BAR(0);} }while(0)
  for(;t+1<NT;t+=2){
    STEP(pB0,pB1,pA0,pA1,t,(t+3<NT),(t+1<NT),(t+1<NT));       ENDW(t);   ROT();
    STEP(pA0,pA1,pB0,pB1,t+1,(t+4<NT),(t+2<NT),(t+2<NT));     ENDW(t+1); ROT();
  }
  STEP(pB0,pB1,pA0,pA1,NT-1,false,false,false);
  { float sacc=pB0[0]+pB0[1]; _Pragma("unroll") for(int r=2;r<16;++r)sacc+=pB0[r]; _Pragma("unroll") for(int r=0;r<16;++r)sacc+=pB1[r]; l_reg+=sacc;
    pw0=(u32x4){PKW(pB0,0),PKW(pB0,2),PKW(pB0,4),PKW(pB0,6)};pw1=(u32x4){PKW(pB0,8),PKW(pB0,10),PKW(pB0,12),PKW(pB0,14)};pw2=(u32x4){PKW(pB1,0),PKW(pB1,2),PKW(pB1,4),PKW(pB1,6)};pw3=(u32x4){PKW(pB1,8),PKW(pB1,10),PKW(pB1,12),PKW(pB1,14)};
    SBAR(); pv(o,vb0+sl_cur,PAF(0),PAF(1),PAF(2),PAF(3)); }
  #undef PKW
  #undef PAF
  #undef VFR
  #undef PIN
  #undef GAPA
  #undef GAPB
  #undef EX
  #undef VRD
  #undef KRD
  #undef STEP
  #undef ENDW
  asm volatile("s_waitcnt lgkmcnt(0)\n\ts_barrier":::"memory");
  if(qb_next>=0){ const bf16*Qn=Q+(rowbase+qb_next*QB+wid*QBLK)*DM+h*D;
    DMA_K(0,0);DMA_V(0,0);DMA_K(1,SLOTB);
    #pragma unroll
    for(int d0=0;d0<4;++d0)qr[d0]=*reinterpret_cast<const bf16x8*>(&Qn[(long)r32*DM+d0*16+hi*8]); }
  float*wsf=(float*)(shm+LDS_WS)+wid*64;
  {auto rr=__builtin_amdgcn_permlane32_swap(__float_as_uint(l_reg),__float_as_uint(l_reg),false,false);l_reg=__uint_as_float(rr[0])+__uint_as_float(rr[1]);}
  if(hi==0)wsf[32+r32]=l_reg;asm volatile("s_waitcnt lgkmcnt(0)":::"memory");
  float rli[16];
  #pragma unroll
  for(int r=0;r<16;++r)rli[r]=__builtin_amdgcn_rcpf(wsf[32+crow(r,hi)]);
  bf16*Ow=O+(rowbase+q0+wid*QBLK)*DM+h*D; const bf16*Gw=SG+(rowbase+q0+wid*QBLK)*DM+h*D;
  { float*stg=(float*)(shm+LDS_OST)+wid*2048;
    #pragma unroll
    for(int r=0;r<16;++r){const int orow=crow(r,hi);
      #pragma unroll
      for(int d0=0;d0<2;++d0)stg[orow*64+d0*32+r32]=o[d0][r]*rli[r];}
    asm volatile("s_waitcnt lgkmcnt(0)":::"memory");
    #pragma unroll
    for(int i=0;i<4;++i){const int row=i*8+(lane>>3),ch=lane&7; const f32x4 v0=*(const f32x4*)(stg+row*64+ch*8), v1=*(const f32x4*)(stg+row*64+ch*8+4);
      const u32x4 g=__builtin_nontemporal_load((const u32x4*)(Gw+(long)row*DM+ch*8)); u32x4 w;
      w.x=cvtpk_s(v0[0]*__uint_as_float(g.x<<16),v0[1]*__uint_as_float(g.x&0xffff0000u)); w.y=cvtpk_s(v0[2]*__uint_as_float(g.y<<16),v0[3]*__uint_as_float(g.y&0xffff0000u));
      w.z=cvtpk_s(v1[0]*__uint_as_float(g.z<<16),v1[1]*__uint_as_float(g.z&0xffff0000u)); w.w=cvtpk_s(v1[2]*__uint_as_float(g.w<<16),v1[3]*__uint_as_float(g.w&0xffff0000u));
      *(u32x4*)(Ow+(long)row*DM+ch*8)=w;} }
  if(qb_next<0) asm volatile("s_waitcnt lgkmcnt(0)\n\ts_barrier":::"memory");
  #undef DMA_K
  #undef DMA_V
  #undef CMASK
  #undef ROT
}
#undef SBAR
#undef WAIT_BAR
}
struct Args { const float* in[29]; float* out; unsigned char* ws; unsigned phmask; int li; };
__global__ void __launch_bounds__(NWAVES * 64, 2) mk_fwd(Args args) {
    extern __shared__ __attribute__((aligned(16))) unsigned char lds_raw[];
    LAS unsigned char* lds = (LAS unsigned char*)lds_raw;
    volatile LAS unsigned* MISC = (volatile LAS unsigned*)(lds + MISC_OFF);
    const int tid0 = threadIdx.x;
    const int G0 = gridDim.x; const int bx0 = blockIdx.x; const int vcu0 = (G0 % 8 == 0) ? (bx0 % 8) * (G0 / 8) + bx0 / 8 : bx0;
    for (int u = tid0; u < (LDS_BYTES - LDSCTL_OFF) / 4; u += NWAVES * 64) ((LAS unsigned*)(lds + LDSCTL_OFF))[u] = 0u;
    __syncthreads();
    XcdBarrier bar = xcd_barrier_post((unsigned*)(args.ws + WS_CTL) + CW_BAR + args.li * XCD_BAR_WORDS, MISC + 8);
    const unsigned mask = args.phmask; bool first = true;
#define SEAM() do { if (!first) { if (ph == 1 || ph == 7) __syncthreads(); else if (ph != 2 && MISC[10] != 0u) xcd_local_barrier(bar); else xcd_barrier(bar); } first = false; } while (0)
#ifndef PH_EN
#define PH_EN 0xFFFFu
#endif
#define IN(p) (((PH_EN >> (p)) & 1u) && (mask & (1u << (p))))

#pragma unroll 1
    for (int it = 0; it < 15; ++it) {
        const int ph = (it == 1) ? 7 : (it >= 2 && it <= 7) ? it - 1 : it;
        if (!IN(ph)) continue;
        SEAM();
        const int reg = __builtin_amdgcn_readfirstlane((int)MISC[10]), xcc = __builtin_amdgcn_readfirstlane((int)bar.x), rank = __builtin_amdgcn_readfirstlane((int)MISC[11]);
        int tid = tid0, vcu = reg ? xcc * 32 + rank : vcu0, G = G0, bx = reg ? rank * 8 + xcc : bx0; unsigned long long zoff = 0ull; asm volatile("" : "+v"(tid), "+s"(vcu), "+s"(zoff), "+s"(G), "+s"(bx));
        unsigned char* ws = args.ws + zoff;
        const int lane = tid & 63, wave = __builtin_amdgcn_readfirstlane(tid >> 6), gw = vcu * NWAVES + wave, NGW = G * NWAVES;
        bf16* XB = (bf16*)(ws + WS_XB); float* SSQ = (float*)(ws + WS_SSQ);
#define ACT_PTR(flat_off, arena_off, row_bytes) (reg ? ws + WS_ACT + (size_t)xcc * ARENA_BYTES + (arena_off) - (size_t)xcc * 2048 * (row_bytes) : ws + (flat_off))
        unsigned char* pUG = ACT_PTR(WS_UG, 0, 4096); unsigned char* pGV = ACT_PTR(WS_GV, 8 * MiB, 4096);
        unsigned char* pXBR = ACT_PTR(WS_XBR, 0, 3072); unsigned char* pLSG = ACT_PTR(WS_LSG, 6 * MiB, 3072); unsigned char* pLY = ACT_PTR(WS_LY, 12 * MiB, 3072);
        unsigned char* pQ = ACT_PTR(WS_Q, 0, 2048); unsigned char* pK = ACT_PTR(WS_K, 4 * MiB, 2048); unsigned char* pV = ACT_PTR(WS_V, 8 * MiB, 2048); unsigned char* pFSG = ACT_PTR(WS_FSG, 12 * MiB, 2048);
#undef ACT_PTR
        switch (ph) {
        case 0: p0_weights<0>(args, ws, lds, gw, NGW, lane, wave); break;
        case 7: p0_weights<1>(args, ws, lds, gw, NGW, lane, wave); break;
        case 1: p_prep(args.in[0], XB, SSQ, gw, NGW, lane); break;
        case 2: case 12: {
            pg8::Gemm g{XB, (const bf16*)(ws + (ph == 2 ? WS_W0IN : WS_W3IN)), M_, 6144, 1024}; pg8::StaticOrder S; S.init(M_, 6144, G, bx);
            pg8::EpiGmlp1 E{(const LAS float*)(lds + RSTD_TAB_OFF), (bf16*)pUG, (bf16*)pGV, (float*)(ws + WS_VSSQ), 0, SSQ};
            pg8::gemm_phase<pg8::EpiGmlp1, pg8::StaticOrder, true, true>(lds, g, S, E); } break;
        case 3: case 13: {
            const float* g_vnorm = ph == 3 ? args.in[3] : args.in[25]; const float* g_ws = ph == 3 ? args.in[4] : args.in[26]; const float* g_bs = ph == 3 ? args.in[5] : args.in[27];
            mix_phase_w(lds, 4 * (vcu >> 3), vcu & 7, (vcu < 256) ? 4 : 0, (const bf16*)pGV, (bf16*)pUG, (const float*)(ws + WS_VSSQ), g_ws, g_bs, g_vnorm, tid, lane, wave);
            __syncthreads(); } break;
        case 4: case 8: case 11: case 14: {
            const bf16* A = (const bf16*)(ph == 8 ? pLY : (ph == 11 ? pQ : pUG));
            const bf16* Bt = (const bf16*)(ws + (ph == 4 ? WS_W0OUT : ph == 8 ? WS_W1OUT : ph == 11 ? WS_W2OUT : WS_W3OUT));
            const int K = ph == 8 ? 1536 : (ph == 11 ? 1024 : 2048);
            pg8::Gemm g{A, Bt, M_, 1024, K}; pg8::StaticOrder S; S.init(M_, 1024, G, bx);
            pg8::EpiRes E{args.in[0], args.out, XB, SSQ, ph == 14 ? 2 : 1};
            pg8::gemm_phase<pg8::EpiRes, pg8::StaticOrder, false, true>(lds, g, S, E); } break;
        case 5: {
            pg8::Gemm g{XB, (const bf16*)(ws + WS_W1IN), M_, 3072, 1024}; pg8::StaticOrder S; S.init(M_, 3072, G, bx);
            pg8::EpiLru1 E{(const LAS float*)(lds + RSTD_TAB_OFF), (bf16*)pXBR, (bf16*)pLSG, 0, SSQ};
            pg8::gemm_phase<pg8::EpiLru1, pg8::StaticOrder, true, true>(lds, g, S, E); } break;
        case 6: {
            for (int I = vcu; I < 256; I += G)
                lru_item(lds, I >> 5, (I >> 1) & 15, I & 1, (const bf16*)pXBR, (const bf16*)pLSG, (bf16*)pLY, (const bf16*)(ws + WS_WAT), (const bf16*)(ws + WS_WXT), args.in[9], args.in[10], args.in[12], args.in[14], args.in[15], tid, lane, wave);
            } break;
        case 9: {
            pg8::Gemm g{XB, (const bf16*)(ws + WS_W2IN), M_, 4096, 1024}; pg8::StaticOrder S; S.init(M_, 4096, G, bx);
            { LAS float* GT = (LAS float*)(lds + RSTD_TAB_OFF + 6144); if (tid < 64) GT[tid] = args.in[20][tid] * attn_body::C2; else if (tid < 128) GT[tid] = args.in[21][tid - 64]; }
            pg8::EpiFox1 E{(const LAS float*)(lds + RSTD_TAB_OFF), (bf16*)pQ, (bf16*)pK, (bf16*)pV, (bf16*)pFSG, (const LAS float*)(lds + RSTD_TAB_OFF + 6144), 0, SSQ};
            pg8::gemm_phase<pg8::EpiFox1, pg8::StaticOrder, true, true>(lds, g, S, E);
            flogit_phase(XB, (const bf16*)(ws + WS_WF), SSQ, args.in[19], (float*)(ws + WS_LOGF), vcu, G, wave, lane); } break;
        case 10: {
            bf16* FQ = (bf16*)pQ; const float* LOGF = (const float*)(ws + WS_LOGF);
            const int bh = vcu >> 1, sl = vcu & 1, ab = bh >> 4, ah = bh & 15;
            { LAS float* cum = (LAS float*)(lds + attn_body::LDS_CUM); LAS float* wt = (LAS float*)(lds + attn_body::LDS_WS);
              const f32x4 lf4 = *(const f32x4*)(LOGF + ((size_t)ab * 16 + ah) * SEQ_ + 4 * tid); float v0 = lf4[0], v1 = lf4[1], v2 = lf4[2], v3 = lf4[3];
              v1 += v0; v2 += v1; v3 += v2; float s = v3;
#pragma unroll
              for (int o = 1; o < 64; o <<= 1) { const float n = __shfl_up(s, o); if (lane >= o) s += n; }
              if (lane == 63) wt[wave] = s;
              __syncthreads();
              float off = s - v3; for (int w = 0; w < wave; ++w) off += wt[w];
              const float k = 1.4426950408889634f;
              *(LAS f32x4*)(cum + 4 * tid) = (f32x4){(v0 + off) * k, (v1 + off) * k, (v2 + off) * k, (v3 + off) * k};
              __syncthreads(); }
            float mq = fabsf(args.in[20][lane]), mk = fabsf(args.in[21][lane]);
#pragma unroll
            for (int o = 1; o < 64; o <<= 1) { mq = fmaxf(mq, __shfl_xor(mq, o)); mk = fmaxf(mk, __shfl_xor(mk, o)); }
            const float mref = attn_body::C2 * 64.0f * mq * mk;
            pg8::bf16x8 qreg[4];
#pragma unroll
            for (int d0 = 0; d0 < 4; ++d0) qreg[d0] = (pg8::bf16x8){0, 0, 0, 0, 0, 0, 0, 0};
#define ATT_QB(i_) (sl == 0 ? ((i_) == 0 ? 7 : (i_) == 1 ? 4 : (i_) == 2 ? 3 : 0) : ((i_) == 0 ? 6 : (i_) == 1 ? 5 : (i_) == 2 ? 2 : 1))
#pragma unroll 1
            for (int i = 0; i < 4; ++i)
                attn_body::attn_unit(ab, ah, ATT_QB(i), FQ, (const bf16*)pK, (const bf16*)pV, (const bf16*)pFSG, FQ, (char*)lds_raw, mref, qreg, i > 0, i < 3 ? ATT_QB(i + 1) : -1);
#undef ATT_QB
            } break;
        default: break;
        }
    }
#undef SEAM
#undef IN
}
extern "C" void kernel_launch(void* const* d_in, const int* in_sizes, int n_in, void* d_out, int out_size, void* d_ws, size_t ws_size, hipStream_t stream) {
    static int grid = 0;
    if (grid == 0) {
        if (n_in != 29 || in_sizes[0] != M_ * DM_ || out_size != M_ * DM_ || ws_size < WS_END) { fprintf(stderr, "kernel_launch: unexpected shapes (n_in %d, ws %zu)\n", n_in, ws_size); grid = -1; return; }
        int dev = 0, cus = 0;
        if (hipGetDevice(&dev) != hipSuccess || hipDeviceGetAttribute(&cus, hipDeviceAttributeMultiprocessorCount, dev) != hipSuccess) { grid = -1; return; }
        if (hipFuncSetAttribute((const void*)mk_fwd, hipFuncAttributeMaxDynamicSharedMemorySize, LDS_BYTES) != hipSuccess) { fprintf(stderr, "kernel_launch: hipFuncSetAttribute failed\n"); grid = -1; return; }
        int per_cu = 0;
        if (hipOccupancyMaxActiveBlocksPerMultiprocessor(&per_cu, (const void*)mk_fwd, NWAVES * 64, LDS_BYTES) != hipSuccess || per_cu < 1) fprintf(stderr, "kernel_launch: occupancy query says %d\n", per_cu);
        (void)hipGetLastError();
        grid = cus;
        if (grid != 256) fprintf(stderr, "kernel_launch: built for a 256-CU device (one out-projection tile / LRU item / attention head pair per CU); got %d CUs\n", grid);
    }
    if (grid < 0) return;
    (void)hipMemsetAsync((char*)d_ws + WS_CTL, 0, CTL_ZERO_BYTES, stream);
    Args a{};
    for (int i = 0; i < 29; ++i) a.in[i] = (const float*)d_in[i];
    a.out = (float*)d_out; a.ws = (unsigned char*)d_ws; a.phmask = 0x7FFFu; a.li = 0;
    hipLaunchKernelGGL(mk_fwd, dim3(grid), dim3(NWAVES * 64), LDS_BYTES, stream, a);
}
```
